# Optimizing an MI355X kernel written in HIP

```python
import math
import jax, jax.numpy as jnp
from jax import lax
import numpy as np

D_MODEL = 1024
BATCH = 32
SEQ = 256
DEPTH = 2
DEC_BATCH = 4
DEC_SEQ = 4096
PAST_LEN = 256

GRID_W = 64
N_MIXERS = 2
N_DA = (DEPTH + 1) // 2
N_ML = DEPTH // 2
DA_HEADS = 8
DA_DK = 64
DA_DV = 2 * DA_DK
DA_QK = DA_HEADS * 2 * DA_DK
DA_V = DA_HEADS * DA_DV
ML_HEADS = 4
ML_DK = D_MODEL // 2 // ML_HEADS
ML_DV = D_MODEL // ML_HEADS
ML_QK = ML_HEADS * ML_DK
ML_V = ML_HEADS * ML_DV
ML_GATES = 2 * 2 * ML_HEADS
ML_IN = 2 * ML_QK + 2 * ML_V + ML_GATES
ML_CHUNK = 64
CONV_W = 3
D_FF = 2816
Q_BLOCK = 128
ROPE_THETA = 10000.0
ALPHA = (2 * DEPTH) ** 0.25
BETA = (8 * DEPTH) ** -0.25
EPS = 1e-5

kernel_name = 'hybrid_diffattn_mlstm_dit_step'


def layer_norm(x, g, b):
    xf = x.astype(jnp.float32)
    mu = jnp.mean(xf, axis=-1, keepdims=True)
    var = jnp.mean(jnp.square(xf - mu), axis=-1, keepdims=True)
    return ((xf - mu) * lax.rsqrt(var + EPS) * g + b).astype(x.dtype)


def post_norm(x, y, g, b):
    return layer_norm(ALPHA * x + y, g, b)


def modulate(x, shift, scale):
    return x * (1 + scale) + shift


def dwconv3(x, w, b):
    L = x.shape[1]
    xp = jnp.pad(x, ((0, 0), (1, 1), (0, 0)))
    return xp[:, :L] * w[0] + xp[:, 1:L + 1] * w[1] + xp[:, 2:] * w[2] + b


def conv_ffn(h, w_up, conv_w, conv_b, w_down):
    u = dwconv3(h @ w_up, conv_w, conv_b)
    g, val = jnp.split(u, 2, axis=-1)
    return (jax.nn.silu(g) * val) @ w_down


def rope_2d(x):
    L = x.shape[1]
    rows = L // GRID_W
    row = jnp.repeat(jnp.arange(rows), GRID_W).astype(jnp.float32)
    col = jnp.tile(jnp.arange(GRID_W), rows).astype(jnp.float32)
    half = DA_DK // 2
    nf = half // 2
    inv = ROPE_THETA ** (-jnp.arange(nf, dtype=jnp.float32) / nf)

    def rot(xa, pos):
        ang = pos[:, None] * inv[None, :]
        cos = jnp.cos(ang)[None, :, None, None, :]
        sin = jnp.sin(ang)[None, :, None, None, :]
        x1, x2 = xa[..., :nf], xa[..., nf:]
        return jnp.concatenate([x1 * cos - x2 * sin, x2 * cos + x1 * sin], axis=-1)

    xf = x.astype(jnp.float32)
    return jnp.concatenate([rot(xf[..., :half], row), rot(xf[..., half:], col)], axis=-1).astype(x.dtype)


def da_project(h, w_qkv):
    B, L, _ = h.shape
    q, k, v = jnp.split(h @ w_qkv, [DA_QK, 2 * DA_QK], axis=-1)
    return (q.reshape(B, L, DA_HEADS, 2, DA_DK), k.reshape(B, L, DA_HEADS, 2, DA_DK),
            v.reshape(B, L, DA_HEADS, DA_DV))


def da_lambda(lam, layer):
    lam_init = 0.8 - 0.6 * math.exp(-0.3 * layer)
    lf = lam.astype(jnp.float32)
    lam_full = jnp.exp(jnp.sum(lf[0] * lf[1])) - jnp.exp(jnp.sum(lf[2] * lf[3])) + lam_init
    return lam_full, lam_init


def diff_attend(q, k, v, lam):
    B, Lq = q.shape[:2]
    nb = Lq // Q_BLOCK
    qb = jnp.moveaxis(q.reshape(B, nb, Q_BLOCK, DA_HEADS, 2, DA_DK), 1, 0)
    scale = DA_DK ** -0.5

    def block(qi):
        s = jnp.einsum('bqhmd,bkhmd->bhmqk', qi, k).astype(jnp.float32) * scale
        p = jax.nn.softmax(s, axis=-1)
        a = (p[:, :, 0] - lam * p[:, :, 1]).astype(v.dtype)
        return jnp.einsum('bhqk,bkhd->bqhd', a, v)

    o = lax.map(block, qb)
    return jnp.moveaxis(o, 0, 1).reshape(B, Lq, DA_HEADS, DA_DV)


def da_output(o, subln_w, lam_init, w_o):
    B, L = o.shape[:2]
    of = o.astype(jnp.float32)
    of = of * lax.rsqrt(jnp.mean(jnp.square(of), axis=-1, keepdims=True) + EPS) * subln_w
    of = of * (1.0 - lam_init)
    return of.astype(o.dtype).reshape(B, L, DA_V) @ w_o


def ml_project(h, w_in, conv_w, conv_b, b_gate):
    B, L, _ = h.shape
    qk, v, o, gates = jnp.split(h @ w_in, [2 * ML_QK, 2 * ML_QK + ML_V, 2 * ML_QK + 2 * ML_V], axis=-1)
    qk = jax.nn.silu(dwconv3(qk, conv_w, conv_b))
    q, k = jnp.split(qk, 2, axis=-1)
    q = q.reshape(B, L, ML_HEADS, ML_DK).transpose(0, 2, 1, 3)
    k = k.reshape(B, L, ML_HEADS, ML_DK).transpose(0, 2, 1, 3) * (ML_DK ** -0.5)
    v = v.reshape(B, L, ML_HEADS, ML_DV).transpose(0, 2, 1, 3)
    gates = (gates + b_gate).astype(jnp.float32).reshape(B, L, 2, 2, ML_HEADS)
    gates = jnp.transpose(gates, (2, 3, 0, 4, 1))
    ig = gates[:, 0]
    lf = jax.nn.log_sigmoid(gates[:, 1])
    return q, k, v, o, ig, lf


def mlstm_scan(q, k, v, ig, lf, C0, n0, m0):
    B, H, L, _ = q.shape
    nc = L // ML_CHUNK

    def chunks(x):
        x = x.astype(jnp.float32).reshape((B, H, nc, ML_CHUNK) + x.shape[3:])
        return jnp.moveaxis(x, 2, 0)

    tril = jnp.tril(jnp.ones((ML_CHUNK, ML_CHUNK), dtype=bool))

    def step(carry, inp):
        C, n, m = carry
        qc, kc, vc, ic, fc = inp
        b = jnp.cumsum(fc, axis=-1)
        intra = jnp.where(tril, b[..., :, None] - b[..., None, :] + ic[..., None, :], -jnp.inf)
        inter = b + m[..., None]
        m_row = jnp.maximum(inter, jnp.max(intra, axis=-1))
        w_intra = jnp.exp(intra - m_row[..., None])
        w_inter = jnp.exp(inter - m_row)
        s = jnp.einsum('bhtd,bhsd->bhts', qc, kc) * w_intra
        num = w_inter[..., None] * jnp.einsum('bhtd,bhde->bhte', qc, C) + jnp.einsum('bhts,bhse->bhte', s, vc)
        den = w_inter * jnp.einsum('bhtd,bhd->bht', qc, n) + jnp.sum(s, axis=-1)
        h = num / jnp.maximum(jnp.abs(den), jnp.exp(-m_row))[..., None]
        b_last = b[..., -1]
        dec = b_last[..., None] - b + ic
        m_new = jnp.maximum(b_last + m, jnp.max(dec, axis=-1))
        w_s = jnp.exp(dec - m_new[..., None])
        carry_w = jnp.exp(b_last + m - m_new)
        C_new = carry_w[..., None, None] * C + jnp.einsum('bhs,bhsd,bhse->bhde', w_s, kc, vc)
        n_new = carry_w[..., None] * n + jnp.einsum('bhs,bhsd->bhd', w_s, kc)
        return (C_new, n_new, m_new), h

    carry0 = (C0.astype(jnp.float32), n0.astype(jnp.float32), m0.astype(jnp.float32))
    (C, n, m), h = lax.scan(step, carry0, (chunks(q), chunks(k), chunks(v), chunks(ig), chunks(lf)))
    h = jnp.moveaxis(h, 0, 2).reshape(B, H, L, ML_DV)
    return h, C, n, m


def ml_bidir(q, k, v, ig, lf, C0, n0, m0):
    hf, Cf, nf, mf = mlstm_scan(q, k, v, ig[0], lf[0], C0[:, 0], n0[:, 0], m0[:, 0])
    rev = lambda x: jnp.flip(x, axis=2)
    hb, Cb, nb, mb = mlstm_scan(rev(q), rev(k), rev(v), rev(ig[1]), rev(lf[1]), C0[:, 1], n0[:, 1], m0[:, 1])
    h = hf + rev(hb)
    return h, jnp.stack([Cf, Cb], axis=1), jnp.stack([nf, nb], axis=1), jnp.stack([mf, mb], axis=1)


def ml_output(h, o, norm_w, w_out):
    B, H, L, _ = h.shape
    mu = jnp.mean(h, axis=-1, keepdims=True)
    var = jnp.mean(jnp.square(h - mu), axis=-1, keepdims=True)
    hn = (h - mu) * lax.rsqrt(var + EPS) * norm_w.astype(jnp.float32)[:, None, :]
    hn = hn.transpose(0, 2, 1, 3).reshape(B, L, ML_V).astype(o.dtype)
    return (jax.nn.sigmoid(o) * hn) @ w_out


def setup_inputs(seed: int = 0) -> dict:
    key = jax.random.key(seed)
    ks = jax.random.split(key, 32)
    nrm = lambda k, shape, s: jax.random.normal(k, shape, jnp.float32) * s
    ada_b = jnp.concatenate([nrm(ks[6], (DEPTH, 2, 2 * D_MODEL), 0.02),
                             1.0 + nrm(ks[7], (DEPTH, 2, D_MODEL), 0.02)], axis=-1).reshape(DEPTH, 6 * D_MODEL)
    ib = nrm(ks[16], (N_ML, 2, 1, ML_HEADS), 0.1)
    fb = jnp.linspace(3.0, 6.0, ML_HEADS, dtype=jnp.float32)[None, None, None, :] + nrm(ks[17], (N_ML, 2, 1, ML_HEADS), 0.1)
    ml_b_gate = jnp.concatenate([ib, fb], axis=2).reshape(N_ML, ML_GATES)
    return {
        'x_prompt': nrm(ks[0], (BATCH, SEQ, D_MODEL), 1.0),
        'x_sample': nrm(ks[1], (DEC_BATCH, DEC_SEQ, D_MODEL), 1.0),
        'c': nrm(ks[2], (DEC_BATCH, D_MODEL), 1.0),
        'cache_k': nrm(ks[3], (DEC_BATCH, N_DA, PAST_LEN, DA_HEADS, 2, DA_DK), 1.0),
        'cache_v': nrm(ks[4], (DEC_BATCH, N_DA, PAST_LEN, DA_HEADS, DA_DV), 1.0),
        'state_C': nrm(ks[24], (DEC_BATCH, N_ML, 2, ML_HEADS, ML_DK, ML_DV), 0.5),
        'state_n': nrm(ks[25], (DEC_BATCH, N_ML, 2, ML_HEADS, ML_DK), 0.5),
        'state_m': nrm(ks[26], (DEC_BATCH, N_ML, 2, ML_HEADS), 1.0),
        'c_ctx': nrm(ks[5], (D_MODEL,), 1.0),
        'ada_w': nrm(ks[8], (DEPTH, D_MODEL, 6 * D_MODEL), 0.02),
        'ada_b': ada_b,
        'ln_g': 1.0 + nrm(ks[9], (DEPTH, 2, D_MODEL), 0.02),
        'ln_b': nrm(ks[10], (DEPTH, 2, D_MODEL), 0.02),
        'da_w_qkv': nrm(ks[11], (N_DA, D_MODEL, 2 * DA_QK + DA_V), D_MODEL ** -0.5),
        'da_lam': nrm(ks[12], (N_DA, 4, DA_DK), 0.1),
        'da_subln': 1.0 + nrm(ks[13], (N_DA, DA_DV), 0.02),
        'da_w_o': nrm(ks[14], (N_DA, DA_V, D_MODEL), BETA * DA_V ** -0.5),
        'ml_w_in': nrm(ks[15], (N_ML, D_MODEL, ML_IN), D_MODEL ** -0.5),
        'ml_conv_w': nrm(ks[18], (N_ML, CONV_W, 2 * ML_QK), 0.5),
        'ml_conv_b': nrm(ks[19], (N_ML, 2 * ML_QK), 0.02),
        'ml_b_gate': ml_b_gate,
        'ml_norm_w': 1.0 + nrm(ks[20], (N_ML, ML_HEADS, ML_DV), 0.02),
        'ml_w_out': nrm(ks[21], (N_ML, ML_V, D_MODEL), BETA * ML_V ** -0.5),
        'ffn_w_up': nrm(ks[22], (DEPTH, D_MODEL, 2 * D_FF), D_MODEL ** -0.5),
        'ffn_conv_w': nrm(ks[23], (DEPTH, CONV_W, 2 * D_FF), 0.5),
        'ffn_conv_b': nrm(ks[27], (DEPTH, 2 * D_FF), 0.02),
        'ffn_w_down': nrm(ks[28], (DEPTH, D_FF, D_MODEL), BETA * D_FF ** -0.5),
    }


def reference(x_prompt, x_sample, c, cache_k, cache_v, state_C, state_n, state_m, c_ctx,
              ada_w, ada_b, ln_g, ln_b, da_w_qkv, da_lam, da_subln, da_w_o,
              ml_w_in, ml_conv_w, ml_conv_b, ml_b_gate, ml_norm_w, ml_w_out,
              ffn_w_up, ffn_conv_w, ffn_conv_b, ffn_w_down):
    cond_p = jax.nn.silu(c_ctx)
    cond_s = jax.nn.silu(c)
    xp, xs = x_prompt, x_sample
    bp = x_prompt.shape[0]
    new_k, new_v, new_C, new_n, new_m = [], [], [], [], []
    for i in range(DEPTH):
        j = i // N_MIXERS
        mod_p = jnp.split(cond_p @ ada_w[i] + ada_b[i], 6, axis=-1)
        mod_s = jnp.split((cond_s @ ada_w[i] + ada_b[i])[:, None, :], 6, axis=-1)
        hp = modulate(xp, mod_p[0], mod_p[1])
        hs = modulate(xs, mod_s[0], mod_s[1])
        if i % N_MIXERS == 0:
            lam, lam_init = da_lambda(da_lam[j], i)
            qp, kp, vp = da_project(hp, da_w_qkv[j])
            yp = da_output(diff_attend(qp, kp, vp, lam), da_subln[j], lam_init, da_w_o[j])
            new_k.append(kp)
            new_v.append(vp)
            qs, ks_, vs = da_project(hs, da_w_qkv[j])
            k_all = jnp.concatenate([cache_k[:, j], rope_2d(ks_)], axis=1)
            v_all = jnp.concatenate([cache_v[:, j], vs], axis=1)
            ys = da_output(diff_attend(rope_2d(qs), k_all, v_all, lam), da_subln[j], lam_init, da_w_o[j])
        else:
            qp, kp, vp, op, igp, lfp = ml_project(hp, ml_w_in[j], ml_conv_w[j], ml_conv_b[j], ml_b_gate[j])
            zC = jnp.zeros((bp, 2, ML_HEADS, ML_DK, ML_DV), jnp.float32)
            zn = jnp.zeros((bp, 2, ML_HEADS, ML_DK), jnp.float32)
            zm = jnp.zeros((bp, 2, ML_HEADS), jnp.float32)
            hpm, Cp, npn, mpm = ml_bidir(qp, kp, vp, igp, lfp, zC, zn, zm)
            yp = ml_output(hpm, op, ml_norm_w[j], ml_w_out[j])
            new_C.append(Cp)
            new_n.append(npn)
            new_m.append(mpm)
            qs, ks_, vs, os_, igs, lfs = ml_project(hs, ml_w_in[j], ml_conv_w[j], ml_conv_b[j], ml_b_gate[j])
            hsm, _, _, _ = ml_bidir(qs, ks_, vs, igs, lfs, state_C[:, j], state_n[:, j], state_m[:, j])
            ys = ml_output(hsm, os_, ml_norm_w[j], ml_w_out[j])
        xp = post_norm(xp, mod_p[2] * yp, ln_g[i, 0], ln_b[i, 0])
        xs = post_norm(xs, mod_s[2] * ys, ln_g[i, 0], ln_b[i, 0])
        hp = modulate(xp, mod_p[3], mod_p[4])
        hs = modulate(xs, mod_s[3], mod_s[4])
        fp = conv_ffn(hp, ffn_w_up[i], ffn_conv_w[i], ffn_conv_b[i], ffn_w_down[i])
        fs = conv_ffn(hs, ffn_w_up[i], ffn_conv_w[i], ffn_conv_b[i], ffn_w_down[i])
        xp = post_norm(xp, mod_p[5] * fp, ln_g[i, 1], ln_b[i, 1])
        xs = post_norm(xs, mod_s[5] * fs, ln_g[i, 1], ln_b[i, 1])
    return (xp, xs, jnp.stack(new_k, axis=1), jnp.stack(new_v, axis=1), jnp.stack(new_C, axis=1), jnp.stack(new_n, axis=1), jnp.stack(new_m, axis=1))
```

```cpp
#include <hip/hip_runtime.h>
#include <hip/hip_cooperative_groups.h>
#include <cstdint>
#include <cstdio>
namespace cg = cooperative_groups;

#ifndef MULTI_LAUNCH
#define MULTI_LAUNCH 0
#endif

#define LAS __attribute__((address_space(3)))
typedef unsigned short bf16_t;
typedef short bf16x8 __attribute__((ext_vector_type(8)));
typedef short bf16x4 __attribute__((ext_vector_type(4)));
typedef float f32x4 __attribute__((ext_vector_type(4)));
typedef float f32x16 __attribute__((ext_vector_type(16)));
typedef unsigned u32x4 __attribute__((ext_vector_type(4)));
typedef unsigned u32x2 __attribute__((ext_vector_type(2)));

constexpr int D = 1024, TP = 8192, TS = 16384, T = 24576, SEQP = 256, SEQS = 4096, LKS = 4352;
constexpr int DFF = 2816, NUP = 5632, NIN = 3088, NINP = 3328;
constexpr float ALPHA = 1.41421356237f, LN_EPS = 1e-5f;
constexpr float QSCALE = 0.125f * 1.44269504089f;
constexpr int NTHREADS = 512;

constexpr size_t WS_CTL = 0;
constexpr size_t WS_WOUT = 16384;
constexpr size_t WS_MOD  = WS_WOUT + (size_t)1024 * 1024 * 2;
constexpr size_t WS_ROPE = WS_MOD + (size_t)2 * 5 * 6144 * 4;
constexpr size_t WS_GATE = WS_ROPE + 8192;
constexpr size_t WS_STAT = WS_GATE + (size_t)T * 16 * 4;
constexpr size_t WS_XA   = WS_STAT + (size_t)T * 2 * 4;
constexpr size_t WS_BIG  = WS_XA + (size_t)(T + 256) * 1024 * 2;
constexpr size_t WS_Q    = WS_BIG;
constexpr size_t WS_KP   = WS_Q + (size_t)T * 1024 * 2;
constexpr size_t WS_VTP  = WS_KP + (size_t)TP * 1024 * 2;
constexpr size_t WS_KS   = WS_VTP + (size_t)TP * 1024 * 2;
constexpr size_t WS_VTS  = WS_KS + (size_t)4 * LKS * 1024 * 2;
constexpr size_t WS_END_ATT = WS_VTS + (size_t)4 * LKS * 1024 * 2;
constexpr size_t WS_ACT  = WS_BIG;
constexpr size_t WS_QKPRE = WS_BIG;
constexpr size_t WS_V     = WS_QKPRE + (size_t)T * 1024 * 2;
constexpr size_t WS_OG    = WS_V + (size_t)T * 1024 * 2;
constexpr size_t WS_TAIL = WS_END_ATT;
constexpr size_t WS_WQKV = WS_TAIL;
constexpr size_t WS_WO   = WS_WQKV + (size_t)3072 * 1024 * 2;
constexpr size_t WS_WIN  = WS_WO + (size_t)1024 * 1024 * 2;
constexpr size_t WS_WUP0 = WS_WIN + (size_t)NINP * 1024 * 2;
constexpr size_t WS_WDN0 = WS_WUP0 + (size_t)NUP * 1024 * 2;
constexpr size_t WS_TAIL_END0 = WS_WDN0 + (size_t)1024 * DFF * 2;
constexpr size_t WS_HB   = WS_TAIL;
constexpr size_t WS_WUP1 = WS_TAIL;
constexpr size_t WS_WDN1 = WS_WUP1 + (size_t)NUP * 1024 * 2;
constexpr size_t WS_END  = WS_TAIL + (size_t)T * 1024 * 2;
static_assert(WS_OG + (size_t)T * 1024 * 2 <= WS_END_ATT && WS_ACT + (size_t)T * DFF * 2 <= WS_END_ATT, "ws map");
static_assert(WS_TAIL_END0 <= WS_END && WS_WDN1 + (size_t)1024 * DFF * 2 <= WS_END, "tail map");
static_assert(WS_END <= (size_t)256 * 1024 * 1024, "workspace over 256 MiB");

constexpr size_t OUT_Y = 0, OUT_K = 25165824, OUT_V = 33554432, OUT_C = 41943040, OUT_N = 50331648, OUT_M = 50364416;

struct Params {
    const float* in[27];
    float* out;
    unsigned char* ws;
    int ph_lo, ph_hi;
};

typedef __bf16 bf16v2_t __attribute__((ext_vector_type(2)));
typedef float f32x2_t __attribute__((ext_vector_type(2)));
__device__ __forceinline__ unsigned cvt_pk_bf16(float lo, float hi) { const f32x2_t v = {lo, hi}; const bf16v2_t b = __builtin_convertvector(v, bf16v2_t); return __builtin_bit_cast(unsigned, b); }
__device__ __forceinline__ bf16_t f2bf(float x) { return (bf16_t)(cvt_pk_bf16(x, 0.f) & 0xffffu); }
__device__ __forceinline__ float bf2f(unsigned v) { return __uint_as_float(v << 16); }
__device__ __forceinline__ float bflo(unsigned v) { return __uint_as_float(v << 16); }
__device__ __forceinline__ float bfhi(unsigned v) { return __uint_as_float(v & 0xffff0000u); }
__device__ __forceinline__ float silu_f(float x) { return x * __builtin_amdgcn_rcpf(1.f + __expf(-x)); }
__device__ __forceinline__ float sigmoid_f(float x) { return __builtin_amdgcn_rcpf(1.f + __expf(-x)); }
__device__ __forceinline__ float wave_sum(float v) {
#pragma unroll
    for (int o = 1; o < 64; o <<= 1) v += __shfl_xor(v, o);
    return v;
}
__device__ __forceinline__ int mod_group(int row) { return row < TP ? 0 : 1 + ((row - TP) >> 12); }

namespace pg8 {
constexpr int BM = 256, BK = 64, HALF = 128, HTB = HALF * BK * 2, STAGE_BYTES = 8 * HTB, NXCD = 8, WGM = 8;
__host__ __device__ __forceinline__ int lds_byte(int r, int c) { const int st = (r >> 4) * 2 + (c >> 5), rr = r & 15, cc = c & 31, ob = rr * 64 + cc * 2; return st * 1024 + (ob ^ (((ob >> 9) & 1) << 5)); }
__host__ __device__ __forceinline__ void stage_rc(int b, int& R, int& C) { const int st = b / 1024, sb = b % 1024, swz = sb ^ (((sb >> 9) & 1) << 5); R = (st >> 1) * 16 + swz / 64; C = (st & 1) * 32 + (swz % 64) / 2; }
struct Unit { int pm, pn, nbj, coff; };
struct Gemm { const bf16_t* A; const bf16_t* Bt; int K; int amode; };
__device__ __forceinline__ long a_row0(int amode, int pm) {
    if (amode == 0 || pm < 32) return (long)pm * 256;
    const int s = pm - 32, b = s / 17, t = s - b * 17;
    return (long)TP + b * SEQS + t * 254 - 1;
}
struct StaticOrder {
    int nM, nN, nwg, G, c, nfull;
    __device__ __forceinline__ void init(int nM_, int nN_, int G_, int c_, bool halves = false) { nM = nM_; nN = nN_; nwg = nM * nN; G = G_; c = c_; nfull = nwg;
        if (halves) { const int nf = (nwg / G) * G; if (2 * (nwg - nf) <= G) nfull = nf; } }
    __device__ __forceinline__ bool next(int i, Unit& u) const {
        const long L = (long)i * G + c; u.nbj = 2; u.coff = 0;
        int wgid;
        if (L < nfull) wgid = (int)L;
        else { const long hh = L - nfull; if (hh >= 2L * (nwg - nfull)) return false; wgid = nfull + (int)(hh >> 1); u.nbj = 1; u.coff = (int)(hh & 1) * 128; } { const int q = nwg / NXCD, r = nwg % NXCD, xcd = wgid % NXCD, off = wgid / NXCD; wgid = (xcd < r ? xcd * (q + 1) : r * (q + 1) + (xcd - r) * q) + off; }
        const int nig = WGM * nN, gid = wgid / nig, fm = gid * WGM, gsz = (nM - fm) < WGM ? (nM - fm) : WGM;
        u.pm = fm + ((wgid % nig) % gsz); u.pn = (wgid % nig) / gsz; return true;
    }
};

template <class Epi, bool HALVES = false, bool PERMB = false>
__device__ __forceinline__ void gemm_phase(LAS unsigned char* lds, const Gemm g, const StaticOrder& S, const Epi& E) {
    const int tid = threadIdx.x, wid = __builtin_amdgcn_readfirstlane(tid >> 6), lane = tid & 63, wr = wid >> 2, wc = wid & 3, fr = lane & 15, fq = lane >> 4;
    const int K = g.K, nt = K / BK;
    unsigned voffA[2], voffB[2];
#pragma unroll
    for (int i = 0; i < 2; ++i) { int R, C; stage_rc(tid * 16 + i * 8192, R, C); voffA[i] = (unsigned)(R * K + C) * 2u;
        int Rb = R; if (PERMB) { const int rho = R & 31, n_ = rho >> 4, i_ = rho & 15; Rb = (R & ~31) + 8 * (i_ >> 2) + 4 * n_ + (i_ & 3); }
        voffB[i] = (unsigned)(Rb * K + C) * 2u; }
    const size_t kstep = (size_t)(BK * 2);
    const size_t hstep = (size_t)HALF * K * 2;
    const size_t tstep = 2 * hstep;
    const size_t rstep = (size_t)K * 2;
    const unsigned ldsw = (unsigned)wid * 1024u;
    const int aoff = lds_byte(wr * 64 + fr, fq * 8), boff = lds_byte(wc * 32 + fr, fq * 8);
#define PG8_SA(b, h) (((b) * 2 + (h)) * HTB)
#define PG8_SB(b, h) ((4 + (b) * 2 + (h)) * HTB)
#define PG8_STAGE(bufoff, gbase, voff) do { _Pragma("unroll") for (int _i = 0; _i < 2; ++_i) \
        __builtin_amdgcn_global_load_lds((const unsigned*)((const char*)(gbase) + (voff)[_i]), (LAS unsigned*)(lds + (bufoff) + ldsw + _i * 8192), 16, 0, 0); } while (0)
#define PG8_LDA(dst, b, h) do { _Pragma("unroll") for (int m = 0; m < 4; ++m) _Pragma("unroll") for (int k = 0; k < 2; ++k) dst[m][k] = *(const LAS bf16x8*)(lds + PG8_SA(b, h) + aoff + m * 2048 + k * 1024); } while (0)
#define PG8_LDB(dst, b, h) do { _Pragma("unroll") for (int n = 0; n < 2; ++n) _Pragma("unroll") for (int k = 0; k < 2; ++k) dst[n][k] = *(const LAS bf16x8*)(lds + PG8_SB(b, h) + boff + n * 2048 + k * 1024); } while (0)
#define PG8_MMA(ai, bj, At, Bt) do { __builtin_amdgcn_s_setprio(1); _Pragma("unroll") for (int m = 0; m < 4; ++m) _Pragma("unroll") for (int n = 0; n < 2; ++n) _Pragma("unroll") for (int k = 0; k < 2; ++k) \
        acc[ai][bj][m][n] = __builtin_amdgcn_mfma_f32_16x16x32_bf16(Bt[n][k], At[m][k], acc[ai][bj][m][n], 0, 0, 0); __builtin_amdgcn_s_setprio(0); } while (0)
#define PG8_WAIT_V(n) asm volatile("s_waitcnt vmcnt(" #n ")" ::: "memory")
#define PG8_WAIT_L(n) asm volatile("s_waitcnt lgkmcnt(" #n ")" ::: "memory")
#define PG8_BAR __builtin_amdgcn_s_barrier()
#define PG8_SCHED __builtin_amdgcn_sched_barrier(0)
    Unit cur, nxt; int ui = 0;
    if (!S.next(0, cur)) return;
    f32x4 acc[2][2][4][2];
#pragma unroll
    for (int a = 0; a < 2; ++a)
#pragma unroll
        for (int b = 0; b < 2; ++b)
#pragma unroll
            for (int m = 0; m < 4; ++m)
#pragma unroll
                for (int n = 0; n < 2; ++n) acc[a][b][m][n] = (f32x4){0.f, 0.f, 0.f, 0.f};
    bf16x8 At[4][2], B0[2][2], B1[2][2];
    const char* cA = (const char*)g.A + a_row0(g.amode, cur.pm) * (long)rstep; const char* cB = (const char*)g.Bt + (size_t)cur.pn * tstep + (size_t)cur.coff * rstep;
    size_t cBh = (!HALVES || cur.nbj == 2) ? hstep : 0;
    PG8_STAGE(PG8_SB(0, 0), cB, voffB); PG8_STAGE(PG8_SB(0, 1), cB + cBh, voffB); PG8_STAGE(PG8_SA(0, 0), cA, voffA); PG8_STAGE(PG8_SA(0, 1), cA + hstep, voffA);
    if (wr == 1) PG8_BAR;
    PG8_WAIT_V(2); PG8_BAR;
    PG8_STAGE(PG8_SB(1, 0), cB + kstep, voffB); PG8_STAGE(PG8_SA(1, 0), cA + kstep, voffA); PG8_STAGE(PG8_SB(1, 1), cB + cBh + kstep, voffB);
    PG8_WAIT_V(6); PG8_BAR;
    for (;;) {
        const bool has_next = S.next(ui + 1, nxt);
        const char* nA = has_next ? (const char*)g.A + a_row0(g.amode, nxt.pm) * (long)rstep : cA; const char* nB = has_next ? (const char*)g.Bt + (size_t)nxt.pn * tstep + (size_t)nxt.coff * rstep : cB;
        const size_t nBh = !HALVES ? hstep : (has_next ? (nxt.nbj == 2 ? hstep : 0) : cBh);
        const bool full = !HALVES || cur.nbj == 2;
        if (full) {
        for (int t = 0; t < nt; t += 2) {
            const bool last = (t == nt - 2);
            const char* a1 = cA + (size_t)(t + 1) * kstep;
            const char* a2 = last ? nA : cA + (size_t)(t + 2) * kstep; const char* b2 = last ? nB : cB + (size_t)(t + 2) * kstep;
            const char* a3 = a2 + kstep; const char* b3 = b2 + kstep; const size_t b2h = last ? nBh : cBh;
            PG8_LDB(B0, 0, 0); PG8_LDB(B1, 0, 1); PG8_SCHED; PG8_LDA(At, 0, 0); PG8_STAGE(PG8_SA(1, 1), a1 + hstep, voffA);
            PG8_WAIT_V(8); PG8_WAIT_L(0); PG8_BAR; PG8_MMA(0, 0, At, B0); PG8_MMA(0, 1, At, B1); PG8_BAR; PG8_SCHED;
            PG8_LDA(At, 0, 1); PG8_STAGE(PG8_SB(0, 0), b2, voffB); PG8_STAGE(PG8_SB(0, 1), b2 + b2h, voffB); PG8_STAGE(PG8_SA(0, 0), a2, voffA);
            PG8_WAIT_V(8); PG8_WAIT_L(0); PG8_BAR; PG8_MMA(1, 0, At, B0); PG8_MMA(1, 1, At, B1); PG8_BAR; PG8_SCHED;
            PG8_LDB(B0, 1, 0); PG8_LDB(B1, 1, 1); PG8_SCHED; PG8_LDA(At, 1, 0); PG8_STAGE(PG8_SA(0, 1), a2 + hstep, voffA);
            PG8_WAIT_V(8); PG8_WAIT_L(0); PG8_BAR; PG8_MMA(0, 0, At, B0); PG8_MMA(0, 1, At, B1); PG8_BAR; PG8_SCHED;
            PG8_LDA(At, 1, 1); PG8_STAGE(PG8_SB(1, 0), b3, voffB); PG8_STAGE(PG8_SB(1, 1), b3 + b2h, voffB); PG8_STAGE(PG8_SA(1, 0), a3, voffA);
            PG8_WAIT_V(8); PG8_WAIT_L(0); PG8_BAR; PG8_MMA(1, 0, At, B0); PG8_MMA(1, 1, At, B1); PG8_BAR; PG8_SCHED;
        }
        } else {
        for (int t = 0; t < nt; t += 2) {
            const bool last = (t == nt - 2);
            const char* a1 = cA + (size_t)(t + 1) * kstep;
            const char* a2 = last ? nA : cA + (size_t)(t + 2) * kstep; const char* b2 = last ? nB : cB + (size_t)(t + 2) * kstep;
            const char* a3 = a2 + kstep; const char* b3 = b2 + kstep; const size_t b2h = last ? nBh : cBh;
            PG8_LDB(B0, 0, 0); PG8_LDB(B1, 0, 1); PG8_SCHED; PG8_LDA(At, 0, 0); PG8_STAGE(PG8_SA(1, 1), a1 + hstep, voffA);
            PG8_WAIT_V(8); PG8_WAIT_L(0); PG8_BAR; PG8_MMA(0, 0, At, B0);  PG8_BAR; PG8_SCHED;
            PG8_LDA(At, 0, 1); PG8_STAGE(PG8_SB(0, 0), b2, voffB); PG8_STAGE(PG8_SB(0, 1), b2 + b2h, voffB); PG8_STAGE(PG8_SA(0, 0), a2, voffA);
            PG8_WAIT_V(8); PG8_WAIT_L(0); PG8_BAR; PG8_MMA(1, 0, At, B0);  PG8_BAR; PG8_SCHED;
            PG8_LDB(B0, 1, 0); PG8_LDB(B1, 1, 1); PG8_SCHED; PG8_LDA(At, 1, 0); PG8_STAGE(PG8_SA(0, 1), a2 + hstep, voffA);
            PG8_WAIT_V(8); PG8_WAIT_L(0); PG8_BAR; PG8_MMA(0, 0, At, B0);  PG8_BAR; PG8_SCHED;
            PG8_LDA(At, 1, 1); PG8_STAGE(PG8_SB(1, 0), b3, voffB); PG8_STAGE(PG8_SB(1, 1), b3 + b2h, voffB); PG8_STAGE(PG8_SA(1, 0), a3, voffA);
            PG8_WAIT_V(8); PG8_WAIT_L(0); PG8_BAR; PG8_MMA(1, 0, At, B0);  PG8_BAR; PG8_SCHED;
        }
        }
        if (wr == 0) PG8_BAR;
        E(acc, cur, wr, wc, fr, fq, lane);
        if (!has_next) break;
#pragma unroll
        for (int a = 0; a < 2; ++a)
#pragma unroll
            for (int b = 0; b < 2; ++b)
#pragma unroll
                for (int m = 0; m < 4; ++m)
#pragma unroll
                    for (int n = 0; n < 2; ++n) acc[a][b][m][n] = (f32x4){0.f, 0.f, 0.f, 0.f};
        cur = nxt; cA = nA; cB = nB; cBh = nBh; ++ui;
        if (wr == 1) PG8_BAR;
    }
    PG8_WAIT_V(0);
    PG8_BAR;
#undef PG8_SA
#undef PG8_SB
#undef PG8_STAGE
#undef PG8_LDA
#undef PG8_LDB
#undef PG8_MMA
#undef PG8_WAIT_V
#undef PG8_WAIT_L
#undef PG8_BAR
#undef PG8_SCHED
}
}
using pg8::Unit;

struct EpiQKV {
    bf16_t *Q, *KP, *KS, *VTP, *VTS; float *outK, *outV; const float* rope;
    __device__ __forceinline__ void operator()(f32x4 (&acc)[2][2][4][2], const Unit& u, int wr, int wc, int fr, int fq, int lane) const {
        const int row0 = u.pm * 256 + wr * 64 + fr;
        const int colt = u.pn * 256, sect = colt >> 10, cb = (colt & 1023) + wc * 32 + 4 * fq;
        const bool sample = row0 >= TP;
#pragma unroll
        for (int ai = 0; ai < 2; ++ai)
#pragma unroll
            for (int m = 0; m < 4; ++m) {
                const int row = row0 + ai * 128 + m * 16;
                const int sb = (row - TP) >> 12, pos = (row - TP) & 4095;
#pragma unroll
                for (int bj = 0; bj < 2; ++bj) {
                    f32x4 v0 = acc[ai][bj][m][0], v1 = acc[ai][bj][m][1];
                    const int c0 = cb + bj * 128;
                    if (sect < 2) {
                        if (sample) {
                            const int p = (wc & 1) ? (pos & 63) : (pos >> 6);
                            const f32x4* rp = (const f32x4*)(rope + (p * 16 + 4 * fq) * 2);
                            const f32x4 r0 = rp[0], r1 = rp[1];
                            const float cs[4] = {r0[0], r0[2], r1[0], r1[2]}, sn[4] = {r0[1], r0[3], r1[1], r1[3]};
#pragma unroll
                            for (int i = 0; i < 4; ++i) { const float x1 = v0[i], x2 = v1[i]; v0[i] = x1 * cs[i] - x2 * sn[i]; v1[i] = x2 * cs[i] + x1 * sn[i]; }
                        }
                        if (sect == 0) {
                            v0 = v0 * QSCALE; v1 = v1 * QSCALE;
                            bf16_t* q = Q + (size_t)row * 1024 + c0;
                            *(u32x2*)q = (u32x2){cvt_pk_bf16(v0[0], v0[1]), cvt_pk_bf16(v0[2], v0[3])};
                            *(u32x2*)(q + 16) = (u32x2){cvt_pk_bf16(v1[0], v1[1]), cvt_pk_bf16(v1[2], v1[3])};
                        } else {
                            bf16_t* kp;
                            if (!sample) { float* o = outK + (size_t)row * 1024 + c0; *(f32x4*)o = v0; *(f32x4*)(o + 16) = v1; kp = KP + (size_t)row * 1024 + c0; }
                            else kp = KS + ((size_t)sb * LKS + 256 + pos) * 1024 + c0;
                            *(u32x2*)kp = (u32x2){cvt_pk_bf16(v0[0], v0[1]), cvt_pk_bf16(v0[2], v0[3])};
                            *(u32x2*)(kp + 16) = (u32x2){cvt_pk_bf16(v1[0], v1[1]), cvt_pk_bf16(v1[2], v1[3])};
                        }
                    } else if (!sample) {
                        float* o = outV + (size_t)row * 1024 + c0; *(f32x4*)o = v0; *(f32x4*)(o + 16) = v1;
                    }
                }
            }
        if (sect == 2) {
#pragma unroll
            for (int ai = 0; ai < 2; ++ai)
#pragma unroll
                for (int bj = 0; bj < 2; ++bj) {
                    const int c0 = cb + bj * 128, h = c0 >> 7, dv = c0 & 127;
                    const int rowb = row0 + ai * 128;
                    bf16_t* vt; size_t ld;
                    if (!sample) { vt = VTP + (((size_t)(rowb >> 8) * 8 + h) * 128 + dv) * 256 + (rowb & 255); ld = 256; }
                    else { vt = VTS + (((size_t)((rowb - TP) >> 12) * 8 + h) * 128 + dv) * LKS + 256 + ((rowb - TP) & 4095); ld = LKS; }
#pragma unroll
                    for (int n = 0; n < 2; ++n)
#pragma unroll
                        for (int i = 0; i < 4; ++i)
#pragma unroll
                            for (int m = 0; m < 4; ++m) vt[(size_t)(16 * n + i) * ld + 16 * m] = f2bf(acc[ai][bj][m][n][i]);
                }
        }
    }
};

struct EpiRes {
    const float *xp, *xs;
    float* Y; const float* gate;
    const float *stat, *lg, *lb;
    __device__ __forceinline__ void operator()(f32x4 (&acc)[2][2][4][2], const Unit& u, int wr, int wc, int fr, int fq, int lane) const {
        const int row0 = u.pm * 256 + wr * 64 + fr, c00 = u.pn * 256 + u.coff + wc * 32 + 4 * fq;
        const float* gp = gate + (size_t)mod_group(row0) * 6144 + c00;
#pragma unroll
        for (int bj = 0; bj < 2; ++bj) {
            if (bj == 1 && u.nbj == 1) continue;
            f32x4 gv[2], g4[2], b4[2];
#pragma unroll
            for (int n = 0; n < 2; ++n) {
                const int co = bj * 128 + n * 16;
                gv[n] = *(const f32x4*)(gp + co); g4[n] = (f32x4){1.f, 1.f, 1.f, 1.f}; b4[n] = (f32x4){0.f, 0.f, 0.f, 0.f};
                if (stat) { g4[n] = *(const f32x4*)(lg + c00 + co); b4[n] = *(const f32x4*)(lb + c00 + co); }
            }
#pragma unroll
            for (int ai = 0; ai < 2; ++ai)
#pragma unroll
                for (int m = 0; m < 4; ++m) {
                    const int row = row0 + ai * 128 + m * 16;
                    const float* xr = (row < TP ? xp + (size_t)row * 1024 : xs + (size_t)(row - TP) * 1024) + c00 + bj * 128;
                    float* yr = Y + (size_t)row * 1024 + c00 + bj * 128;
                    f32x4 x0 = *(const f32x4*)xr, x1 = *(const f32x4*)(xr + 16);
                    if (stat) { const float mu = stat[2 * row], rs = stat[2 * row + 1]; x0 = (x0 - mu) * rs * g4[0] + b4[0]; x1 = (x1 - mu) * rs * g4[1] + b4[1]; }
                    *(f32x4*)yr = x0 * ALPHA + gv[0] * acc[ai][bj][m][0];
                    *(f32x4*)(yr + 16) = x1 * ALPHA + gv[1] * acc[ai][bj][m][1];
                }
        }
    }
};

struct EpiFFNUp {
    bf16_t* ACT; const float* cw; const float* cbias;
    LAS float* edge;
    __device__ __forceinline__ void operator()(f32x4 (&acc)[2][2][4][2], const Unit& u, int wr, int wc, int fr, int fq, int lane) const {
        asm volatile("" : "+v"(lane));
        fr = lane & 15; fq = lane >> 4;
        int tok0, pos0, seqlen; bool ovl;
        if (u.pm < 32) { tok0 = u.pm * 256; pos0 = 0; seqlen = 256; ovl = false; }
        else { const int s = u.pm - 32, b = s / 17, t = s - b * 17; pos0 = t * 254 - 1; tok0 = TP + b * SEQS + pos0; seqlen = SEQS; ovl = true; }
        const int rbase = wr * 64 + fr;
#pragma unroll
        for (int ai = 0; ai < 2; ++ai)
#pragma unroll
            for (int m = 0; m < 4; ++m) {
                const int pos = pos0 + ai * 128 + rbase + m * 16;
                if (pos < 0 || pos >= seqlen) {
#pragma unroll
                    for (int bj = 0; bj < 2; ++bj)
#pragma unroll
                        for (int n = 0; n < 2; ++n) acc[ai][bj][m][n] = (f32x4){0.f, 0.f, 0.f, 0.f};
                }
            }
        const int ccol = wc * 32 + 8 * fq;
#pragma unroll
        for (int ai = 0; ai < 2; ++ai) {
            const int rb = ai * 2 + wr;
            if (fr == 0) {
#pragma unroll
                for (int bj = 0; bj < 2; ++bj)
#pragma unroll
                    for (int n = 0; n < 2; ++n) *(LAS f32x4*)(edge + (rb * 2 + 0) * 256 + bj * 128 + n * 4 + ccol) = acc[ai][bj][0][n];
            }
            if (fr == 15) {
#pragma unroll
                for (int bj = 0; bj < 2; ++bj)
#pragma unroll
                    for (int n = 0; n < 2; ++n) *(LAS f32x4*)(edge + (rb * 2 + 1) * 256 + bj * 128 + n * 4 + ccol) = acc[ai][bj][3][n];
            }
        }
        asm volatile("s_waitcnt lgkmcnt(0)" ::: "memory");
        __builtin_amdgcn_s_barrier();
        asm volatile("" ::: "memory");
        const int lp = (lane & 48) | ((fr - 1) & 15), ln = (lane & 48) | ((fr + 1) & 15);
        const int chg = u.pn * 128 + ccol;
#pragma unroll
        for (int bj = 0; bj < 2; ++bj)
#pragma unroll
            for (int n = 0; n < 2; ++n) {
                const int ch = bj * DFF + chg + n * 4;
                const f32x4 w0 = *(const f32x4*)(cw + ch), w1 = *(const f32x4*)(cw + NUP + ch), w2 = *(const f32x4*)(cw + 2 * NUP + ch), bb = *(const f32x4*)(cbias + ch);
#pragma unroll
                for (int ai = 0; ai < 2; ++ai) {
                    const int rb = ai * 2 + wr;
                    f32x4 eprev = (f32x4){0.f, 0.f, 0.f, 0.f}, enext = (f32x4){0.f, 0.f, 0.f, 0.f};
                    if (rb > 0) eprev = *(const LAS f32x4*)(edge + ((rb - 1) * 2 + 1) * 256 + bj * 128 + n * 4 + ccol);
                    if (rb < 3) enext = *(const LAS f32x4*)(edge + ((rb + 1) * 2 + 0) * 256 + bj * 128 + n * 4 + ccol);
#pragma unroll
                    for (int i = 0; i < 4; ++i) {
                        float up[4], dn[4];
#pragma unroll
                        for (int m = 0; m < 4; ++m) { float cv = acc[ai][bj][m][n][i]; asm volatile("" : "+v"(cv)); acc[ai][bj][m][n][i] = cv; const int ci = __builtin_bit_cast(int, cv);
                            up[m] = __builtin_bit_cast(float, __builtin_amdgcn_update_dpp(0, ci, 0x121, 0xf, 0xf, false));
                            dn[m] = __builtin_bit_cast(float, __builtin_amdgcn_update_dpp(0, ci, 0x12F, 0xf, 0xf, false)); }
#pragma unroll
                        for (int m = 0; m < 4; ++m) {
                            const float pv = (fr == 0) ? (m == 0 ? eprev[i] : up[m == 0 ? 0 : m - 1]) : up[m];
                            const float nv = (fr == 15) ? (m == 3 ? enext[i] : dn[m == 3 ? 3 : m + 1]) : dn[m];
                            float rv = w0[i] * pv + w1[i] * acc[ai][bj][m][n][i] + w2[i] * nv + bb[i];
                            asm volatile("" : "+v"(rv));
                            acc[ai][bj][m][n][i] = rv;
                        }
                        __builtin_amdgcn_sched_barrier(0);
                    }
                    asm volatile("" ::: "memory");
                }
            }
#pragma unroll
        for (int ai = 0; ai < 2; ++ai)
#pragma unroll
            for (int m = 0; m < 4; ++m) {
                const int r = ai * 128 + rbase + m * 16, pos = pos0 + r;
                const bool ok = ovl ? (r >= 1 && r <= 254 && pos < seqlen) : true;
                if (ok) {
                    bf16_t* o = ACT + (size_t)(tok0 + r) * DFF + chg;
                    const f32x4 g0 = acc[ai][0][m][0], v0 = acc[ai][1][m][0], g1 = acc[ai][0][m][1], v1 = acc[ai][1][m][1];
                    *(u32x4*)o = (u32x4){cvt_pk_bf16(silu_f(g0[0]) * v0[0], silu_f(g0[1]) * v0[1]), cvt_pk_bf16(silu_f(g0[2]) * v0[2], silu_f(g0[3]) * v0[3]),
                                         cvt_pk_bf16(silu_f(g1[0]) * v1[0], silu_f(g1[1]) * v1[1]), cvt_pk_bf16(silu_f(g1[2]) * v1[2], silu_f(g1[3]) * v1[3])};
                }
            }
    }
};

struct EpiIn {
    bf16_t *QKPRE, *V, *OG; float* GT; const float* bgate;
    __device__ __forceinline__ void operator()(f32x4 (&acc)[2][2][4][2], const Unit& u, int wr, int wc, int fr, int fq, int lane) const {
        const int row0 = u.pm * 256 + wr * 64 + fr;
        const int colt = u.pn * 256, sect = colt >> 10, cb = (colt & 1023) + wc * 32 + 8 * fq;
        if (sect < 3) {
            bf16_t* dst = QKPRE + (size_t)sect * ((size_t)T * 1024);
#pragma unroll
            for (int ai = 0; ai < 2; ++ai)
#pragma unroll
                for (int m = 0; m < 4; ++m) {
                    bf16_t* o = dst + (size_t)(row0 + ai * 128 + m * 16) * 1024 + cb;
#pragma unroll
                    for (int bj = 0; bj < 2; ++bj) {
                        f32x4 v0 = acc[ai][bj][m][0], v1 = acc[ai][bj][m][1];
                        if (sect == 2) {
#pragma unroll
                            for (int i = 0; i < 4; ++i) { v0[i] = sigmoid_f(v0[i]); v1[i] = sigmoid_f(v1[i]); }
                        }
                        *(u32x4*)(o + bj * 128) = (u32x4){cvt_pk_bf16(v0[0], v0[1]), cvt_pk_bf16(v0[2], v0[3]), cvt_pk_bf16(v1[0], v1[1]), cvt_pk_bf16(v1[2], v1[3])};
                    }
                }
        } else if (wc == 0 && fq < 2) {
            const f32x4 bg0 = *(const f32x4*)(bgate + 8 * fq), bg1 = *(const f32x4*)(bgate + 8 * fq + 4);
#pragma unroll
            for (int ai = 0; ai < 2; ++ai)
#pragma unroll
                for (int m = 0; m < 4; ++m) {
                    const f32x4 vi = acc[ai][0][m][0] + bg0;
                    f32x4 vf = acc[ai][0][m][1] + bg1;
#pragma unroll
                    for (int i = 0; i < 4; ++i) vf[i] = fminf(vf[i], 0.f) - log1pf(__expf(-fabsf(vf[i])));
                    float* gp = GT + (size_t)(row0 + ai * 128 + m * 16) * 16 + 8 * fq;
                    *(f32x4*)gp = vi; *(f32x4*)(gp + 4) = vf;
                }
        }
    }
};

__device__ __forceinline__ void transpose_tile(const float* W, int K, int N, bf16_t* WT, int k0, int n0out, int n0src, LAS float* scr) {
    const int tid = threadIdx.x;
    {
        const int n = tid & 63, kk = tid >> 6;
        const bool ok = (n0src >= 0) && (n0src + n < N);
#pragma unroll
        for (int j = 0; j < 8; ++j) { const int k = kk + 8 * j; scr[k * 65 + n] = ok ? __builtin_nontemporal_load(W + (size_t)(k0 + k) * N + n0src + n) : 0.f; }
    }
    __syncthreads();
    {
        const int n = tid >> 3, kc = tid & 7;
        const LAS float* s = scr + (kc * 8) * 65 + n;
        u32x4 o; o.x = cvt_pk_bf16(s[0], s[65]); o.y = cvt_pk_bf16(s[2 * 65], s[3 * 65]); o.z = cvt_pk_bf16(s[4 * 65], s[5 * 65]); o.w = cvt_pk_bf16(s[6 * 65], s[7 * 65]);
        *(u32x4*)(WT + (size_t)(n0out + n) * K + k0 + kc * 8) = o;
    }
    __syncthreads();
}
__device__ __forceinline__ void transpose_job(const float* W, int K, int N, int Nout, bf16_t* WT, int perm_up, int item, LAS float* scr) {
    const int nblk = Nout / 64, kb = item / nblk, nb = item % nblk;
    int n0src = nb * 64;
    if (perm_up) { const int pn = nb >> 2, j = (nb & 3) * 64; n0src = (j < 128) ? 128 * pn + j : DFF + 128 * pn + (j - 128); }
    transpose_tile(W, K, N, WT, kb * 64, nb * 64, n0src, scr);
}

__device__ __forceinline__ void phase_prep(const Params& p, LAS unsigned char* lds) {
    LAS float* scr = (LAS float*)lds;
    const int G = gridDim.x, tid = threadIdx.x;
    unsigned char* ws = p.ws;
    constexpr int I_QKV = 16 * 48, I_O = 16 * 16;
    for (int it = blockIdx.x; it < I_QKV; it += G) {
        if (it < I_QKV) transpose_job(p.in[13], 1024, 3072, 3072, (bf16_t*)(ws + WS_WQKV), 0, it, scr);
        else transpose_job(p.in[16], 1024, 1024, 1024, (bf16_t*)(ws + WS_WO), 0, it - I_QKV, scr);
    }
    __syncthreads();
    {
        LAS float* cond = (LAS float*)lds;
        LAS float* red = cond + 5 * 1024;
        for (int i = tid; i < 5 * 1024; i += NTHREADS) { const int g = i >> 10, k = i & 1023; const float c = g == 0 ? p.in[8][k] : p.in[2][(g - 1) * 1024 + k]; cond[i] = silu_f(c); }
        __syncthreads();
        for (int it = (G - 1 - (int)blockIdx.x); it < 192; it += G) {
            const int l = it / 96, cb = it % 96, c4 = (tid & 15) * 4, kc = tid >> 4;
            const float* w = p.in[9] + (size_t)l * 1024 * 6144 + cb * 64 + c4;
            f32x4 a0 = (f32x4){0.f, 0.f, 0.f, 0.f}, a1 = a0, a2 = a0, a3 = a0, a4 = a0;
#pragma unroll 8
            for (int k = kc * 32; k < kc * 32 + 32; ++k) {
                const f32x4 wv = __builtin_nontemporal_load((const f32x4*)(w + (size_t)k * 6144));
                a0 += wv * cond[k]; a1 += wv * cond[1024 + k]; a2 += wv * cond[2048 + k]; a3 += wv * cond[3072 + k]; a4 += wv * cond[4096 + k];
            }
            *(LAS f32x4*)(red + (kc * 5 + 0) * 64 + c4) = a0; *(LAS f32x4*)(red + (kc * 5 + 1) * 64 + c4) = a1; *(LAS f32x4*)(red + (kc * 5 + 2) * 64 + c4) = a2;
            *(LAS f32x4*)(red + (kc * 5 + 3) * 64 + c4) = a3; *(LAS f32x4*)(red + (kc * 5 + 4) * 64 + c4) = a4;
            __syncthreads();
            for (int o = tid; o < 320; o += NTHREADS) {
                const int g = o >> 6, c = o & 63;
                float s = 0.f;
#pragma unroll 8
                for (int q = 0; q < 32; ++q) s += red[(q * 5 + g) * 64 + c];
                ((float*)(ws + WS_MOD))[((size_t)l * 5 + g) * 6144 + cb * 64 + c] = s + p.in[10][(size_t)l * 6144 + cb * 64 + c];
            }
            __syncthreads();
        }
    }
    const int gt = blockIdx.x * NTHREADS + tid, NGT = G * NTHREADS;
    {
        bf16_t* KS = (bf16_t*)(ws + WS_KS); bf16_t* VTS = (bf16_t*)(ws + WS_VTS);
        for (int i = gt; i < 4 * 256 * 1024 / 4; i += NGT) {
            const int e = i * 4, b = e >> 18, rc = e & 262143;
            const f32x4 v = *(const f32x4*)(p.in[3] + e);
            *(u32x2*)(KS + (size_t)b * LKS * 1024 + rc) = (u32x2){cvt_pk_bf16(v[0], v[1]), cvt_pk_bf16(v[2], v[3])};
        }
        for (int i = gt; i < 4 * 8 * 128 * 256; i += NGT) {
            const int r = i & 255, dv = (i >> 8) & 127, h = (i >> 15) & 7, b = i >> 18;
            VTS[(((size_t)b * 8 + h) * 128 + dv) * LKS + r] = f2bf(p.in[4][(((size_t)b * 256 + r) * 8 + h) * 128 + dv]);
        }
        if (gt < 1024) {
            const int pos = gt >> 4, f = gt & 15;
            const float inv = exp2f(-(float)f * (13.287712379549449f / 16.f));
            const float ang = (float)pos * inv;
            const double rev = (double)ang * 0.15915494309189535;
            const float fr = (float)(rev - floor(rev));
            float* rp = (float*)(ws + WS_ROPE);
            rp[gt * 2] = __builtin_amdgcn_cosf(fr); rp[gt * 2 + 1] = __builtin_amdgcn_sinf(fr);
        }
    }
}

__device__ __forceinline__ void tr_idle(const float* W, int K, int N, int Nout, bf16_t* WT, int perm, LAS unsigned char* lds, int first) {
    const int G = gridDim.x;
    if ((int)blockIdx.x < first) return;
    const int nit = (K / 64) * (Nout / 64);
    for (int it = (int)blockIdx.x - first; it < nit; it += G - first) transpose_job(W, K, N, Nout, WT, perm, it, (LAS float*)lds);
}
__device__ __forceinline__ void prep_ffn1(const Params& p, LAS unsigned char* lds) {
    LAS float* scr = (LAS float*)lds;
    constexpr int I_UP = 16 * 88, I_DN = 44 * 16;
    for (int it = blockIdx.x; it < I_UP + I_DN; it += gridDim.x) {
        if (it < I_UP) transpose_job(p.in[23] + (size_t)1024 * NUP, 1024, NUP, NUP, (bf16_t*)(p.ws + WS_WUP1), 1, it, scr);
        else transpose_job(p.in[26] + (size_t)DFF * 1024, DFF, 1024, 1024, (bf16_t*)(p.ws + WS_WDN1), 0, it - I_UP, scr);
    }
}

__device__ __forceinline__ void phase_modulate_in(const Params& p) {
    const int lane = threadIdx.x & 63, gw = blockIdx.x * 8 + (threadIdx.x >> 6), NGW = gridDim.x * 8;
    const float* mod = (const float*)(p.ws + WS_MOD);
    bf16_t* XA = (bf16_t*)(p.ws + WS_XA);
    for (int row = gw; row < T; row += NGW) {
        const float* xr = row < TP ? p.in[0] + (size_t)row * 1024 : p.in[1] + (size_t)(row - TP) * 1024;
        const float* mg = mod + (size_t)mod_group(row) * 6144;
#pragma unroll
        for (int j = 0; j < 4; ++j) {
            const int c = 4 * lane + 256 * j;
            const f32x4 x = *(const f32x4*)(xr + c), sh = *(const f32x4*)(mg + c), sc = *(const f32x4*)(mg + 1024 + c);
            const f32x4 h = x * (sc + 1.f) + sh;
            *(u32x2*)(XA + (size_t)row * 1024 + c) = (u32x2){cvt_pk_bf16(h[0], h[1]), cvt_pk_bf16(h[2], h[3])};
        }
    }
}
__device__ __forceinline__ void phase_ln(const Params& p, const float* g, const float* b, const float* modl, int shift_chunk, bool write_h, bool write_y) {
    const int lane = threadIdx.x & 63, gw = blockIdx.x * 8 + (threadIdx.x >> 6), NGW = gridDim.x * 8;
    float* Y = p.out + OUT_Y; bf16_t* XA = (bf16_t*)(p.ws + WS_XA);
    f32x4 gv_[4], bv_[4];
#pragma unroll
    for (int j = 0; j < 4; ++j) { gv_[j] = *(const f32x4*)(g + 4 * lane + 256 * j); bv_[j] = *(const f32x4*)(b + 4 * lane + 256 * j); }
    for (int row = gw; row < T; row += NGW) {
        float* yr = Y + (size_t)row * 1024;
        f32x4 v[4]; float s = 0.f;
#pragma unroll
        for (int j = 0; j < 4; ++j) { v[j] = *(const f32x4*)(yr + 4 * lane + 256 * j); s += (v[j][0] + v[j][1]) + (v[j][2] + v[j][3]); }
        const float mean = wave_sum(s) * (1.f / 1024.f); float s2 = 0.f;
#pragma unroll
        for (int j = 0; j < 4; ++j) { v[j] = v[j] - mean; s2 += (v[j][0] * v[j][0] + v[j][1] * v[j][1]) + (v[j][2] * v[j][2] + v[j][3] * v[j][3]); }
        const float rstd = 1.f / sqrtf(wave_sum(s2) * (1.f / 1024.f) + LN_EPS);
        const float* mg = modl + (size_t)mod_group(row) * 6144 + shift_chunk * 1024;
        if (!write_y && lane == 0) { float* st = (float*)(p.ws + WS_STAT) + 2 * row; st[0] = mean; st[1] = rstd; }
#pragma unroll
        for (int j = 0; j < 4; ++j) {
            const int c = 4 * lane + 256 * j;
            const f32x4 x = v[j] * rstd * gv_[j] + bv_[j];
            if (write_y) *(f32x4*)(yr + c) = x;
            if (write_h) {
                const f32x4 sh = *(const f32x4*)(mg + c), sc = *(const f32x4*)(mg + 1024 + c);
                const f32x4 h = x * (sc + 1.f) + sh;
                *(u32x2*)(XA + (size_t)row * 1024 + c) = (u32x2){cvt_pk_bf16(h[0], h[1]), cvt_pk_bf16(h[2], h[3])};
            }
        }
    }
}
__device__ __forceinline__ void phase_mlconv(const Params& p) {
    const int gt = blockIdx.x * NTHREADS + threadIdx.x, NGT = gridDim.x * NTHREADS;
    const bf16_t* PRE = (const bf16_t*)(p.ws + WS_QKPRE); bf16_t* QK = (bf16_t*)(p.ws + WS_XA);
    const float* cw = p.in[18]; const float* cbv = p.in[19];
    const bool fixed_c = (NGT & 127) == 0;
    const int c_fix = (gt & 127) * 8;
    float w0[8], w1[8], w2[8], bb[8];
#pragma unroll
    for (int j = 0; j < 8; ++j) { w0[j] = cw[c_fix + j]; w1[j] = cw[1024 + c_fix + j]; w2[j] = cw[2048 + c_fix + j]; bb[j] = cbv[c_fix + j]; }
    for (int i = gt; i < T * 128; i += NGT) {
        const int row = i >> 7, c = (i & 127) * 8;
        if (!fixed_c) {
#pragma unroll
            for (int j = 0; j < 8; ++j) { w0[j] = cw[c + j]; w1[j] = cw[1024 + c + j]; w2[j] = cw[2048 + c + j]; bb[j] = cbv[c + j]; }
        }
        int pos, L; if (row < TP) { pos = row & 255; L = 256; } else { pos = (row - TP) & 4095; L = 4096; }
        const u32x4 z = (u32x4){0u, 0u, 0u, 0u};
        const u32x4 x1 = *(const u32x4*)(PRE + (size_t)row * 1024 + c);
        const u32x4 x0 = pos > 0 ? *(const u32x4*)(PRE + (size_t)(row - 1) * 1024 + c) : z;
        const u32x4 x2 = pos < L - 1 ? *(const u32x4*)(PRE + (size_t)(row + 1) * 1024 + c) : z;
        const float sc = c >= 512 ? 0.08838834764831845f : 1.f;
        float o[8];
#pragma unroll
        for (int j = 0; j < 4; ++j) {
            const float u0 = w0[2 * j] * bflo(x0[j]) + w1[2 * j] * bflo(x1[j]) + w2[2 * j] * bflo(x2[j]) + bb[2 * j];
            const float u1 = w0[2 * j + 1] * bfhi(x0[j]) + w1[2 * j + 1] * bfhi(x1[j]) + w2[2 * j + 1] * bfhi(x2[j]) + bb[2 * j + 1];
            o[2 * j] = silu_f(u0) * sc; o[2 * j + 1] = silu_f(u1) * sc;
        }
        *(u32x4*)(QK + (size_t)row * 1024 + c) = (u32x4){cvt_pk_bf16(o[0], o[1]), cvt_pk_bf16(o[2], o[3]), cvt_pk_bf16(o[4], o[5]), cvt_pk_bf16(o[6], o[7])};
    }
}
__device__ __forceinline__ void phase_mlout(const Params& p) {
    const int lane = threadIdx.x & 63, gw = blockIdx.x * 8 + (threadIdx.x >> 6), NGW = gridDim.x * 8;
    const bf16_t* H = (const bf16_t*)(p.ws + WS_QKPRE); const bf16_t* HBk = (const bf16_t*)(p.ws + WS_HB); const bf16_t* OG = (const bf16_t*)(p.ws + WS_OG); bf16_t* HN = (bf16_t*)(p.ws + WS_XA);
    const float* nw = p.in[21];
    float nwv[16];
#pragma unroll
    for (int j = 0; j < 16; ++j) nwv[j] = nw[lane * 16 + j];
    for (int row = gw; row < T; row += NGW) {
        const int c = lane * 16;
        const size_t hoff = ((size_t)(lane >> 2) * T + row) * 64 + (lane & 3) * 16;
        const u32x4 h0 = *(const u32x4*)(H + hoff), h1 = *(const u32x4*)(H + hoff + 8);
        const u32x4 b0 = *(const u32x4*)(HBk + hoff), b1 = *(const u32x4*)(HBk + hoff + 8);
        const u32x4 g0 = *(const u32x4*)(OG + (size_t)row * 1024 + c), g1 = *(const u32x4*)(OG + (size_t)row * 1024 + c + 8);
        float x[16], og[16]; float s = 0.f;
#pragma unroll
        for (int j = 0; j < 4; ++j) { x[2 * j] = bflo(h0[j]) + bflo(b0[j]); x[2 * j + 1] = bfhi(h0[j]) + bfhi(b0[j]); x[8 + 2 * j] = bflo(h1[j]) + bflo(b1[j]); x[8 + 2 * j + 1] = bfhi(h1[j]) + bfhi(b1[j]);
            og[2 * j] = bflo(g0[j]); og[2 * j + 1] = bfhi(g0[j]); og[8 + 2 * j] = bflo(g1[j]); og[8 + 2 * j + 1] = bfhi(g1[j]); }
#pragma unroll
        for (int j = 0; j < 16; ++j) s += x[j];
        s += __shfl_xor(s, 1); s += __shfl_xor(s, 2); s += __shfl_xor(s, 4); s += __shfl_xor(s, 8);
        const float mean = s * (1.f / 256.f); float s2 = 0.f;
#pragma unroll
        for (int j = 0; j < 16; ++j) { x[j] -= mean; s2 += x[j] * x[j]; }
        s2 += __shfl_xor(s2, 1); s2 += __shfl_xor(s2, 2); s2 += __shfl_xor(s2, 4); s2 += __shfl_xor(s2, 8);
        const float rstd = 1.f / sqrtf(s2 * (1.f / 256.f) + LN_EPS);
        unsigned o[8];
#pragma unroll
        for (int j = 0; j < 8; ++j) o[j] = cvt_pk_bf16(x[2 * j] * rstd * nwv[2 * j] * og[2 * j], x[2 * j + 1] * rstd * nwv[2 * j + 1] * og[2 * j + 1]);
        *(u32x4*)(HN + (size_t)row * 1024 + c) = (u32x4){o[0], o[1], o[2], o[3]};
        *(u32x4*)(HN + (size_t)row * 1024 + c + 8) = (u32x4){o[4], o[5], o[6], o[7]};
    }
}

constexpr int AT_KSTR = 136, AT_VSTR = 72;
constexpr int AT_KBYTES = 64 * AT_KSTR * 2, AT_VBYTES = 128 * AT_VSTR * 2, AT_BUF = AT_KBYTES + AT_VBYTES;
__device__ __forceinline__ void phase_attn(const Params& p, LAS unsigned char* lds) {
    const int tid = threadIdx.x, lane = tid & 63, w = tid >> 6, mp = w >> 2, qsub = w & 3, l31 = lane & 31, hh = lane >> 5;
    const int G = gridDim.x;
    const int vb = (G % 8 == 0) ? ((int)blockIdx.x % 8) * (G / 8) + (int)blockIdx.x / 8 : (int)blockIdx.x;
    const bf16_t* Q = (const bf16_t*)(p.ws + WS_Q);
    bf16_t* AO = (bf16_t*)(p.ws + WS_XA);
    float lam;
    {
        const float* dl = p.in[14];
        const float s01 = wave_sum(dl[lane] * dl[64 + lane]), s23 = wave_sum(dl[128 + lane] * dl[192 + lane]);
        lam = __expf(s01) - __expf(s23) + 0.2f;
    }
    const float* subln = p.in[15];
    for (int it = vb; it < 1536; it += G) {
        int Lk, qrow0, h; const bf16_t* Kb; const bf16_t* Vb;
        if (it < 1024) { const int b = it >> 8; h = (it >> 5) & 7; const int qt = it & 31; Lk = LKS; qrow0 = TP + b * SEQS + qt * 128;
            Kb = (const bf16_t*)(p.ws + WS_KS) + (size_t)b * LKS * 1024 + h * 128; Vb = (const bf16_t*)(p.ws + WS_VTS) + ((size_t)b * 8 + h) * 128 * LKS; }
        else { const int j = it - 1024, s = j >> 4; h = (j >> 1) & 7; const int qt = j & 1; Lk = 256; qrow0 = s * 256 + qt * 128;
            Kb = (const bf16_t*)(p.ws + WS_KP) + (size_t)s * 256 * 1024 + h * 128; Vb = (const bf16_t*)(p.ws + WS_VTP) + ((size_t)s * 8 + h) * 128 * 256; }
        const int nkt = Lk >> 6;
        const int qrow = qrow0 + qsub * 32 + l31;
        bf16x8 qf[4];
#pragma unroll
        for (int ks = 0; ks < 4; ++ks) qf[ks] = *(const bf16x8*)(Q + (size_t)qrow * 1024 + h * 128 + mp * 64 + ks * 16 + hh * 8);
        u32x4 kr[2], vr[2];
        const int kkey0 = tid >> 4, kch = tid & 15, vdv0 = tid >> 3, vch = tid & 7;
#define AT_LOAD(kt) do { _Pragma("unroll") for (int i = 0; i < 2; ++i) { \
            kr[i] = *(const u32x4*)(Kb + (size_t)((kt) * 64 + kkey0 + 32 * i) * 1024 + kch * 8); \
            vr[i] = *(const u32x4*)(Vb + (size_t)(vdv0 + 64 * i) * Lk + (kt) * 64 + vch * 8); } } while (0)
#define AT_WRITE(buf) do { _Pragma("unroll") for (int i = 0; i < 2; ++i) { \
            *(LAS u32x4*)(lds + (buf) * AT_BUF + ((kkey0 + 32 * i) * AT_KSTR + kch * 8) * 2) = kr[i]; \
            LAS unsigned char* vw_ = lds + (buf) * AT_BUF + AT_KBYTES + ((vdv0 + 64 * i) * AT_VSTR + (vch >> 1) * 16) * 2 + (vch & 1) * 8; \
            *(LAS u32x2*)vw_ = (u32x2){vr[i].x, vr[i].y}; *(LAS u32x2*)(vw_ + 16) = (u32x2){vr[i].z, vr[i].w}; } } while (0)
        AT_LOAD(0); AT_WRITE(0);
        AT_LOAD(1); AT_WRITE(1);
        __syncthreads();
        f32x16 o[4];
#pragma unroll
        for (int dt = 0; dt < 4; ++dt)
#pragma unroll
            for (int r = 0; r < 16; ++r) o[dt][r] = 0.f;
        float mrun = -1e30f, lsum = 0.f;
        f32x16 s[2], sn[2];
#define AT_QK(dst, buf) do { const LAS unsigned char* kb_ = lds + (buf) * AT_BUF; _Pragma("unroll") for (int kb = 0; kb < 2; ++kb) { \
            _Pragma("unroll") for (int r = 0; r < 16; ++r) dst[kb][r] = 0.f; \
            _Pragma("unroll") for (int ks = 0; ks < 4; ++ks) { \
                const bf16x8 a = *(const LAS bf16x8*)(kb_ + ((kb * 32 + l31) * AT_KSTR + mp * 64 + ks * 16 + hh * 8) * 2); \
                dst[kb] = __builtin_amdgcn_mfma_f32_32x32x16_bf16(a, qf[ks], dst[kb], 0, 0, 0); } } } while (0)
#define AT_SOFTMAX(sv, valid, pdst) do { \
            float mx_ = sv[0][0]; \
            _Pragma("unroll") for (int r = 1; r < 16; ++r) mx_ = fmaxf(mx_, sv[0][r]); \
            _Pragma("unroll") for (int r = 0; r < 16; ++r) mx_ = fmaxf(mx_, sv[1][r]); \
            mx_ = fmaxf(mx_, __shfl_xor(mx_, 32)); \
            const float mnew_ = (valid) ? fmaxf(mrun, mx_) : mrun; \
            alpha = __builtin_amdgcn_exp2f(mrun - mnew_); mrun = mnew_; \
            float ps_ = 0.f; \
            _Pragma("unroll") for (int kb = 0; kb < 2; ++kb) { float pv_[16]; \
                _Pragma("unroll") for (int r = 0; r < 16; ++r) { pv_[r] = __builtin_amdgcn_exp2f(sv[kb][r] - mnew_); ps_ += pv_[r]; } \
                _Pragma("unroll") for (int jj = 0; jj < 2; ++jj) { u32x4 t_; t_.x = cvt_pk_bf16(pv_[8 * jj + 0], pv_[8 * jj + 1]); t_.y = cvt_pk_bf16(pv_[8 * jj + 2], pv_[8 * jj + 3]); \
                    t_.z = cvt_pk_bf16(pv_[8 * jj + 4], pv_[8 * jj + 5]); t_.w = cvt_pk_bf16(pv_[8 * jj + 6], pv_[8 * jj + 7]); pdst[kb * 2 + jj] = __builtin_bit_cast(bf16x8, t_); } } \
            lsum = lsum * alpha + ((valid) ? ps_ : 0.f); } while (0)
#define AT_VLD(dst, dt) do { _Pragma("unroll") for (int g = 0; g < 4; ++g) dst[g] = *(const LAS bf16x8*)(vb_ + (((dt) * 32 + l31) * AT_VSTR + g * 16 + hh * 8) * 2); } while (0)
#define AT_PV(src_, dt) do { _Pragma("unroll") for (int g = 0; g < 4; ++g) o[dt] = __builtin_amdgcn_mfma_f32_32x32x16_bf16(src_[g], pb[g], o[dt], 0, 0, 0); } while (0)
        float alpha = 1.f;
        bf16x8 pb[4], pn[4];
        AT_QK(s, 0);
        AT_SOFTMAX(s, true, pb);
        alpha = 1.f;
        int b0 = 0, b1 = 1, b2 = 2;
        if (w >= 4) __builtin_amdgcn_s_setprio(1);
        for (int kt = 0; kt < nkt; ++kt) {
            const bool has1 = kt + 1 < nkt, has2 = kt + 2 < nkt;
            if (has2) AT_LOAD(kt + 2);
            const LAS unsigned char* vb_ = lds + b0 * AT_BUF + AT_KBYTES;
            if (__builtin_amdgcn_ballot_w64(alpha != 1.f) != 0) {
#pragma unroll
                for (int dt = 0; dt < 4; ++dt) o[dt] = o[dt] * alpha;
            }
            bf16x8 vA[4], vB[4];
            AT_VLD(vA, 0);
            AT_QK(sn, b1);
            AT_VLD(vB, 1); AT_PV(vA, 0);
            AT_VLD(vA, 2); AT_PV(vB, 1);
            AT_VLD(vB, 3); AT_PV(vA, 2);
            AT_PV(vB, 3);
            AT_SOFTMAX(sn, has1, pn);
#pragma unroll
            for (int g = 0; g < 4; ++g) pb[g] = pn[g];
            if (has2) AT_WRITE(b2);
            __syncthreads();
            { const int t_ = b0; b0 = b1; b1 = b2; b2 = t_; }
        }
        __builtin_amdgcn_s_setprio(0);
#undef AT_SOFTMAX
#undef AT_VLD
#undef AT_PV
#undef AT_QK
#undef AT_LOAD
#undef AT_WRITE
        const float ltot = lsum + __shfl_xor(lsum, 32), inv = 1.f / ltot;
        LAS float* X = (LAS float*)lds;
        if (mp == 1) {
#pragma unroll
            for (int dt = 0; dt < 4; ++dt)
#pragma unroll
                for (int r = 0; r < 16; ++r) X[(qsub * 64 + dt * 16 + r) * 64 + lane] = o[dt][r] * inv;
        }
        __syncthreads();
        if (mp == 0) {
            float ss = 0.f;
#pragma unroll
            for (int dt = 0; dt < 4; ++dt)
#pragma unroll
                for (int r = 0; r < 16; ++r) { const float v = o[dt][r] * inv - lam * X[(qsub * 64 + dt * 16 + r) * 64 + lane]; o[dt][r] = v; ss += v * v; }
            ss += __shfl_xor(ss, 32);
            const float rms = 0.8f / sqrtf(ss * (1.f / 128.f) + LN_EPS);
            bf16_t* orow = AO + (size_t)qrow * 1024 + h * 128;
#pragma unroll
            for (int dt = 0; dt < 4; ++dt)
#pragma unroll
                for (int r4 = 0; r4 < 4; ++r4) {
                    const int dv = dt * 32 + r4 * 8 + hh * 4;
                    const f32x4 sw = *(const f32x4*)(subln + dv);
                    *(u32x2*)(orow + dv) = (u32x2){cvt_pk_bf16(o[dt][4 * r4] * rms * sw[0], o[dt][4 * r4 + 1] * rms * sw[1]), cvt_pk_bf16(o[dt][4 * r4 + 2] * rms * sw[2], o[dt][4 * r4 + 3] * rms * sw[3])};
                }
        }
        __syncthreads();
    }
}

constexpr int SC_QSTR = 136, SC_TSTR = 72, SC_NSTR = 84, SC_DVS = 64, SC_NT = SC_DVS / 16 + 1, SC_ER = SC_NT * 16;
constexpr int SC_QS = 0, SC_KS = SC_QS + 64 * SC_QSTR * 2, SC_KT = SC_KS + 64 * SC_QSTR * 2, SC_VT = SC_KT + 128 * SC_TSTR * 2, SC_VTW = SC_VT + SC_ER * SC_TSTR * 2,
              SC_SS = SC_VTW + SC_ER * SC_TSTR * 2, SC_CT = SC_SS + 64 * SC_TSTR * 2, SC_NM = SC_CT + SC_ER * SC_QSTR * 2, SC_GA = SC_NM + 64 * SC_NSTR * 4, SC_END = SC_GA + 6 * 256 + 64;
static_assert(SC_END <= 131072, "scan LDS");
__device__ __forceinline__ void phase_scan(const Params& p, LAS unsigned char* lds) {
    const int tid = threadIdx.x, lane = tid & 63, w = tid >> 6, l15 = lane & 15, lq = lane >> 4;
    const int G = gridDim.x;
    const bf16_t* QK = (const bf16_t*)(p.ws + WS_XA); const bf16_t* Vg = (const bf16_t*)(p.ws + WS_V);
    const float* GT = (const float*)(p.ws + WS_GATE);
    LAS bf16_t* Qs = (LAS bf16_t*)(lds + SC_QS); LAS bf16_t* Ks = (LAS bf16_t*)(lds + SC_KS); LAS bf16_t* Kt = (LAS bf16_t*)(lds + SC_KT);
    LAS bf16_t* Vt = (LAS bf16_t*)(lds + SC_VT); LAS bf16_t* Vtw = (LAS bf16_t*)(lds + SC_VTW); LAS bf16_t* Ss = (LAS bf16_t*)(lds + SC_SS);
    LAS bf16_t* Ct = (LAS bf16_t*)(lds + SC_CT); LAS float* Nm = (LAS float*)(lds + SC_NM);
    LAS bf16_t* Vs = (LAS bf16_t*)(lds + SC_NM);
    LAS float* ga = (LAS float*)(lds + SC_GA); LAS float* gM = ga + 64; LAS float* gb = ga + 128; LAS float* gwi = ga + 192; LAS float* gws = ga + 256; LAS float* gsc = ga + 320;
    for (int i = tid; i < 16 * 64; i += NTHREADS) { const int r = SC_DVS + (i >> 6), c = i & 63; Vt[r * SC_TSTR + c] = (r == SC_DVS) ? (bf16_t)0x3F80 : (bf16_t)0; Vtw[r * SC_TSTR + c] = 0; }
    __syncthreads();
    int it0, itstep, itlim;
    if (G >= 256) { if (blockIdx.x < 128) { it0 = blockIdx.x; itstep = 1 << 20; itlim = 128; } else { it0 = 128 + ((int)blockIdx.x - 128); itstep = G - 128; itlim = 1152; } }
    else { it0 = blockIdx.x; itstep = G; itlim = 1152; }
    for (int it = it0; it < itlim; it += itstep) {
        int seqbase, L, h, sl, sidx, dir; bool samp;
        if (it < 128) { samp = true; dir = it >> 6; const int i2 = it & 63; sidx = i2 >> 4; h = (i2 >> 2) & 3; sl = i2 & 3; seqbase = TP + sidx * SEQS; L = SEQS; }
        else { const int j0 = it - 128; dir = j0 >> 9; const int j = j0 & 511; samp = false; sidx = j >> 4; h = (j >> 2) & 3; sl = j & 3; seqbase = sidx * 256; L = 256; }
        bf16_t* H = (bf16_t*)(p.ws + (dir ? WS_HB : WS_QKPRE));
        const int nch = L >> 6;
        f32x4 cst[SC_NT]; float mst;
        if (samp) {
            const size_t sb = (((size_t)sidx * 2 + dir) * 4 + h) * 128;
#pragma unroll
            for (int nt = 0; nt < SC_NT - 1; ++nt)
#pragma unroll
                for (int j = 0; j < 4; ++j) cst[nt][j] = p.in[5][(sb + 16 * w + 4 * lq + j) * 256 + sl * SC_DVS + nt * 16 + l15];
#pragma unroll
            for (int j = 0; j < 4; ++j) cst[SC_NT - 1][j] = (l15 == 0) ? p.in[6][sb + 16 * w + 4 * lq + j] : 0.f;
            mst = p.in[7][((size_t)sidx * 2 + dir) * 4 + h];
        } else {
#pragma unroll
            for (int nt = 0; nt < SC_NT; ++nt) cst[nt] = (f32x4){0.f, 0.f, 0.f, 0.f};
            mst = 0.f;
        }
#pragma unroll
        for (int nt = 0; nt < SC_NT; ++nt)
            *(LAS u32x2*)(Ct + (nt * 16 + l15) * SC_QSTR + 16 * w + 4 * lq) = (u32x2){cvt_pk_bf16(cst[nt][0], cst[nt][1]), cvt_pk_bf16(cst[nt][2], cst[nt][3])};
#define SC_TOKC(cc, t) (seqbase + (dir ? (L - 1 - ((cc) * 64 + (t))) : ((cc) * 64 + (t))))
        u32x4 qr[2], kr[2], vr = (u32x4){0u, 0u, 0u, 0u}; float ig_r = 0.f, lf_r = 0.f;
#define SC_LOAD(cc) do { _Pragma("unroll") for (int i = 0; i < 2; ++i) { const int id_ = tid + 512 * i; const size_t g = (size_t)SC_TOKC(cc, id_ >> 4) * 1024 + h * 128 + (id_ & 15) * 8; \
                qr[i] = *(const u32x4*)(QK + g); kr[i] = *(const u32x4*)(QK + g + 512); } \
            vr = *(const u32x4*)(Vg + (size_t)SC_TOKC(cc, tid >> 3) * 1024 + h * 256 + sl * SC_DVS + (tid & 7) * 8); \
            if (w == 0) { const size_t gi = (size_t)SC_TOKC(cc, lane) * 16 + dir * 8 + h; ig_r = GT[gi]; lf_r = GT[gi + 4]; } } while (0)
        SC_LOAD(0);
        for (int c = 0; c < nch; ++c) {
#define SC_TOK(t) SC_TOKC(c, t)
            if (w == 0) {
                const float ig = ig_r, lf = lf_r;
                float b = lf;
#pragma unroll
                for (int o = 1; o < 64; o <<= 1) { const float t = __shfl_up(b, o); if (lane >= o) b += t; }
                const float a = ig - b;
                float cm = a;
#pragma unroll
                for (int o = 1; o < 64; o <<= 1) { const float t = __shfl_up(cm, o); if (lane >= o) cm = fmaxf(cm, t); }
                const float Mt = fmaxf(mst, cm);
                const float M63 = __shfl(Mt, 63), bl = __shfl(b, 63);
                ga[lane] = a; gM[lane] = Mt; gb[lane] = b; gwi[lane] = __expf(mst - Mt); gws[lane] = __expf(a - M63);
                if (lane == 0) { gsc[0] = bl + M63; gsc[1] = __expf(mst - M63); }
            }
#pragma unroll
            for (int i = 0; i < 2; ++i) { const int id_ = tid + 512 * i, r = id_ >> 4, ch = id_ & 15;
                *(LAS u32x4*)(Qs + r * SC_QSTR + ch * 8) = qr[i]; *(LAS u32x4*)(Ks + r * SC_QSTR + ch * 8) = kr[i]; }
            *(LAS u32x4*)(Vs + (tid >> 3) * SC_TSTR + (tid & 7) * 8) = vr;
            __syncthreads();
#pragma unroll
            for (int i = 0; i < 2; ++i) { const int r = lane, ch = 2 * w + i; const u32x4 kv = *(const LAS u32x4*)(Ks + r * SC_QSTR + ch * 8);
#pragma unroll
                for (int j = 0; j < 4; ++j) { Kt[(ch * 8 + 2 * j) * SC_TSTR + r] = (bf16_t)(kv[j] & 0xffffu); Kt[(ch * 8 + 2 * j + 1) * SC_TSTR + r] = (bf16_t)(kv[j] >> 16); } }
            { const int r = lane, e0 = w * 8; const float ws_ = gws[r]; const u32x4 vv = *(const LAS u32x4*)(Vs + r * SC_TSTR + e0);
#pragma unroll
                for (int j = 0; j < 4; ++j) { Vt[(e0 + 2 * j) * SC_TSTR + r] = (bf16_t)(vv[j] & 0xffffu); Vt[(e0 + 2 * j + 1) * SC_TSTR + r] = (bf16_t)(vv[j] >> 16);
                    Vtw[(e0 + 2 * j) * SC_TSTR + r] = f2bf(bflo(vv[j]) * ws_); Vtw[(e0 + 2 * j + 1) * SC_TSTR + r] = f2bf(bfhi(vv[j]) * ws_); }
                if (w == 4) Vtw[SC_DVS * SC_TSTR + r] = f2bf(ws_); }
            if (c + 1 < nch) SC_LOAD(c + 1);
#pragma unroll
            for (int ti = 0; ti < 2; ++ti) {
                const int id = 2 * w + ti, tt = id >> 2, st = id & 3;
                f32x4 sa = (f32x4){0.f, 0.f, 0.f, 0.f};
                if (st <= tt) {
#pragma unroll
                    for (int kk = 0; kk < 4; ++kk) {
                        const bf16x8 a = *(const LAS bf16x8*)(Qs + (tt * 16 + l15) * SC_QSTR + kk * 32 + lq * 8);
                        const bf16x8 b = *(const LAS bf16x8*)(Ks + (st * 16 + l15) * SC_QSTR + kk * 32 + lq * 8);
                        sa = __builtin_amdgcn_mfma_f32_16x16x32_bf16(a, b, sa, 0, 0, 0);
                    }
                    const int s_ = st * 16 + l15; const float as = ga[s_];
#pragma unroll
                    for (int j = 0; j < 4; ++j) { const int t_ = tt * 16 + lq * 4 + j; sa[j] = (s_ <= t_) ? sa[j] * __expf(as - gM[t_]) : 0.f; }
                }
#pragma unroll
                for (int j = 0; j < 4; ++j) Ss[(tt * 16 + lq * 4 + j) * SC_TSTR + st * 16 + l15] = f2bf(sa[j]);
            }
            __syncthreads();
            for (int id = w; id < 4 * SC_NT; id += 8) {
                const int tt = id / SC_NT, et = id - tt * SC_NT;
                f32x4 na = (f32x4){0.f, 0.f, 0.f, 0.f};
#pragma unroll
                for (int kk = 0; kk < 4; ++kk) {
                    const bf16x8 a = *(const LAS bf16x8*)(Qs + (tt * 16 + l15) * SC_QSTR + kk * 32 + lq * 8);
                    const bf16x8 b = *(const LAS bf16x8*)(Ct + (et * 16 + l15) * SC_QSTR + kk * 32 + lq * 8);
                    na = __builtin_amdgcn_mfma_f32_16x16x32_bf16(a, b, na, 0, 0, 0);
                }
#pragma unroll
                for (int j = 0; j < 4; ++j) na[j] *= gwi[tt * 16 + lq * 4 + j];
#pragma unroll
                for (int kk = 0; kk < 2; ++kk) {
                    const bf16x8 a = *(const LAS bf16x8*)(Ss + (tt * 16 + l15) * SC_TSTR + kk * 32 + lq * 8);
                    const bf16x8 b = *(const LAS bf16x8*)(Vt + (et * 16 + l15) * SC_TSTR + kk * 32 + lq * 8);
                    na = __builtin_amdgcn_mfma_f32_16x16x32_bf16(a, b, na, 0, 0, 0);
                }
#pragma unroll
                for (int j = 0; j < 4; ++j) Nm[(tt * 16 + lq * 4 + j) * SC_NSTR + et * 16 + l15] = na[j];
            }
            {
                const float carry = gsc[1];
#pragma unroll
                for (int nt = 0; nt < SC_NT; ++nt) {
                    cst[nt] = cst[nt] * carry;
#pragma unroll
                    for (int kk = 0; kk < 2; ++kk) {
                        const bf16x8 a = *(const LAS bf16x8*)(Kt + (16 * w + l15) * SC_TSTR + kk * 32 + lq * 8);
                        const bf16x8 b = *(const LAS bf16x8*)(Vtw + (nt * 16 + l15) * SC_TSTR + kk * 32 + lq * 8);
                        cst[nt] = __builtin_amdgcn_mfma_f32_16x16x32_bf16(a, b, cst[nt], 0, 0, 0);
                    }
                }
                mst = gsc[0];
            }
            __syncthreads();
            {
                const int t_ = tid >> 3, e0 = (tid & 7) * 8;
                const float den = fmaxf(fabsf(Nm[t_ * SC_NSTR + SC_DVS]), __expf(-gb[t_] - gM[t_]));
                const float rd = __builtin_amdgcn_rcpf(den);
                const f32x4 nv = *(const LAS f32x4*)(Nm + t_ * SC_NSTR + e0), nw = *(const LAS f32x4*)(Nm + t_ * SC_NSTR + e0 + 4);
                bf16_t* hp = H + ((size_t)(h * 4 + sl) * T + SC_TOK(t_)) * SC_DVS + e0;
                *(u32x4*)hp = (u32x4){cvt_pk_bf16(nv[0] * rd, nv[1] * rd), cvt_pk_bf16(nv[2] * rd, nv[3] * rd), cvt_pk_bf16(nw[0] * rd, nw[1] * rd), cvt_pk_bf16(nw[2] * rd, nw[3] * rd)};
            }
#pragma unroll
            for (int nt = 0; nt < SC_NT; ++nt)
                *(LAS u32x2*)(Ct + (nt * 16 + l15) * SC_QSTR + 16 * w + 4 * lq) = (u32x2){cvt_pk_bf16(cst[nt][0], cst[nt][1]), cvt_pk_bf16(cst[nt][2], cst[nt][3])};
            __syncthreads();
#undef SC_TOK
        }
#undef SC_LOAD
#undef SC_TOKC
        if (!samp) {
            const size_t sb = (((size_t)sidx * 2 + dir) * 4 + h) * 128;
#pragma unroll
            for (int nt = 0; nt < SC_NT - 1; ++nt)
#pragma unroll
                for (int j = 0; j < 4; ++j) p.out[OUT_C + (sb + 16 * w + 4 * lq + j) * 256 + sl * SC_DVS + nt * 16 + l15] = cst[nt][j];
            if (sl == 0) {
                if (l15 == 0) {
#pragma unroll
                    for (int j = 0; j < 4; ++j) p.out[OUT_N + sb + 16 * w + 4 * lq + j] = cst[SC_NT - 1][j];
                }
                if (tid == 0) p.out[OUT_M + ((size_t)sidx * 2 + dir) * 4 + h] = mst;
            }
        }
    }
}

#define XB_TMO      128
#define XB_XCNT(j)  (256  + 64 * (j))
#define XB_XSUB(j)  (1280 + 64 * (j))
#define XB_XGEN(j)  (2304 + 64 * (j))
#define XB_TOP      3328
#define XB_TOPGEN   3392
#define XB_SPIN_CAP (1u << 18)
__device__ __forceinline__ unsigned xb_ld(unsigned* p)              { return __hip_atomic_load(p, __ATOMIC_RELAXED, __HIP_MEMORY_SCOPE_AGENT); }
__device__ __forceinline__ unsigned xb_add(unsigned* p, unsigned v) { return __hip_atomic_fetch_add(p, v, __ATOMIC_RELAXED, __HIP_MEMORY_SCOPE_AGENT); }
__device__ __forceinline__ unsigned xb_xcc_id() { return (unsigned)__builtin_amdgcn_s_getreg((3 << 11) | 20) & 0xFu; }
#define XB_SPIN(cond, bar) do { unsigned _sp = 0; while (cond) { __builtin_amdgcn_s_sleep(1); \
    if ((++_sp & 255u) == 0u) { if (xb_ld(&(bar)[XB_TMO])) break; if (_sp > XB_SPIN_CAP) { atomicAdd(&(bar)[XB_TMO], 1u); break; } } } } while (0)
struct XcdBarrier { unsigned* bar; unsigned x; volatile LAS unsigned* st; };
__device__ __forceinline__ XcdBarrier xcd_barrier_post(unsigned* bar, volatile LAS unsigned* st) {
    XcdBarrier b; b.bar = bar; b.x = xb_xcc_id(); b.st = st;
    if (threadIdx.x == 0) (void)xb_add(&bar[XB_XCNT(b.x)], 1u);
    return b;
}
__device__ __forceinline__ void xcd_barrier_complete(unsigned* bar, unsigned x, unsigned& nloc, unsigned& nx) {
    const unsigned G = gridDim.x * gridDim.y * gridDim.z;
    unsigned sum, cnt, mine, sp = 0u;
    for (;;) {
        sum = 0u; cnt = 0u; mine = 0u;
#pragma unroll
        for (unsigned j = 0; j < 16; ++j) { const unsigned c = xb_ld(&bar[XB_XCNT(j)]); sum += c; cnt += (c > 0u) ? 1u : 0u; mine = (j == x) ? c : mine; }
        if (sum == G) break;
        __builtin_amdgcn_s_sleep(1);
        if ((++sp & 255u) == 0u) { if (xb_ld(&bar[XB_TMO])) break; if (sp > XB_SPIN_CAP) { atomicAdd(&bar[XB_TMO], 1u); break; } }
    }
    nloc = mine > 0u ? mine : 1u; nx = cnt > 0u ? cnt : 1u;
}
__device__ __forceinline__ void xcd_barrier(const XcdBarrier& b) {
    asm volatile("s_waitcnt vmcnt(0) lgkmcnt(0)" ::: "memory");
    __syncthreads();
    if (threadIdx.x == 0) {
        unsigned* bar = b.bar;
        __builtin_amdgcn_s_waitcnt(0);
        unsigned nloc = b.st[0], nx = b.st[1];
        if (nloc == 0u) { xcd_barrier_complete(bar, b.x, nloc, nx); b.st[0] = nloc; b.st[1] = nx; }
        const unsigned old = xb_add(&bar[XB_XSUB(b.x)], 1u);
        const unsigned gen = old / nloc;
        if (old + 1u == (gen + 1u) * nloc) {
            __builtin_amdgcn_fence(__ATOMIC_RELEASE, "agent");
            asm volatile("s_waitcnt vmcnt(0)" ::: "memory");
            const unsigned og = xb_add(&bar[XB_TOP], 1u);
            const unsigned tg = og / nx;
            if (og + 1u == (tg + 1u) * nx) xb_add(&bar[XB_TOPGEN], 1u);
            else XB_SPIN(xb_ld(&bar[XB_TOPGEN]) == tg, bar);
            __builtin_amdgcn_fence(__ATOMIC_ACQUIRE, "agent");
            xb_add(&bar[XB_XGEN(b.x)], 1u);
            asm volatile("s_waitcnt vmcnt(0)" ::: "memory");
        } else {
            XB_SPIN(xb_ld(&bar[XB_XGEN(b.x)]) == gen, bar);
            __builtin_amdgcn_fence(__ATOMIC_ACQUIRE, "agent");
            asm volatile("s_waitcnt vmcnt(0)" ::: "memory");
        }
    }
    __syncthreads();
}

constexpr int LDS_ST_OFF = pg8::STAGE_BYTES + 8192;
constexpr int LDS_BYTES = LDS_ST_OFF + 16;
constexpr int NPHASE = 18;

__global__ void __launch_bounds__(NTHREADS, 2) fwd_kernel(Params p) {
    extern __shared__ __attribute__((aligned(16))) unsigned char lds_raw[];
    LAS unsigned char* lds = (LAS unsigned char*)lds_raw;
    cg::grid_group grid = cg::this_grid();
    const int G = gridDim.x;
    unsigned char* ws = p.ws;
    const float* mod = (const float*)(ws + WS_MOD);
    bf16_t* XA = (bf16_t*)(ws + WS_XA);
    float* Y = p.out + OUT_Y;
#define IN(k) (p.ph_lo <= (k) && (k) < p.ph_hi)
    LAS unsigned* xst = (LAS unsigned*)(lds + LDS_ST_OFF);
    if (threadIdx.x == 0) { xst[0] = 0u; xst[1] = 0u; xst[2] = 0u; xst[3] = 0u; }
    __syncthreads();
    const XcdBarrier xb = xcd_barrier_post((unsigned*)(ws + WS_CTL), (volatile LAS unsigned*)xst);
    if (p.ph_lo < 0) grid.sync();
#define SEAM(k) do { if (IN(k) && IN((k) + 1)) xcd_barrier(xb); } while (0)
    if (IN(0)) phase_prep(p, lds);
    SEAM(0);
    if (IN(1)) phase_modulate_in(p);
    SEAM(1);
    if (IN(2)) {
        pg8::Gemm g{XA, (const bf16_t*)(ws + WS_WQKV), 1024, 0}; pg8::StaticOrder S; S.init(96, 12, G, blockIdx.x);
        EpiQKV E{(bf16_t*)(ws + WS_Q), (bf16_t*)(ws + WS_KP), (bf16_t*)(ws + WS_KS), (bf16_t*)(ws + WS_VTP), (bf16_t*)(ws + WS_VTS), p.out + OUT_K, p.out + OUT_V, (const float*)(ws + WS_ROPE)};
        pg8::gemm_phase(lds, g, S, E);
        tr_idle(p.in[23], 1024, NUP, NUP, (bf16_t*)(ws + WS_WUP0), 1, lds, 1152 % G);
        tr_idle(p.in[26], DFF, 1024, 1024, (bf16_t*)(ws + WS_WDN0), 0, lds, 1152 % G);
        tr_idle(p.in[16], 1024, 1024, 1024, (bf16_t*)(ws + WS_WO), 0, lds, 1152 % G);
    }
    SEAM(2);
    if (IN(3)) phase_attn(p, lds);
    SEAM(3);
    if (IN(4)) {
        pg8::Gemm g{XA, (const bf16_t*)(ws + WS_WO), 1024, 0}; pg8::StaticOrder S; S.init(96, 4, G, blockIdx.x, true);
        EpiRes E{p.in[0], p.in[1], Y, mod + 2 * 1024, nullptr, nullptr, nullptr};
        pg8::gemm_phase<EpiRes, true>(lds, g, S, E);
    }
    SEAM(4);
    if (IN(5)) phase_ln(p, p.in[11], p.in[12], mod, 3, true, false);
    SEAM(5);
    if (IN(6)) {
        pg8::Gemm g{XA, (const bf16_t*)(ws + WS_WUP0), 1024, 1}; pg8::StaticOrder S; S.init(100, 22, G, blockIdx.x);
        EpiFFNUp E{(bf16_t*)(ws + WS_ACT), p.in[24], p.in[25], (LAS float*)(lds + pg8::STAGE_BYTES)};
        pg8::gemm_phase<EpiFFNUp, false, true>(lds, g, S, E);
        tr_idle(p.in[17], 1024, NIN, NINP, (bf16_t*)(ws + WS_WIN), 0, lds, 2200 % G);
        tr_idle(p.in[22], 1024, 1024, 1024, (bf16_t*)(ws + WS_WOUT), 0, lds, 2200 % G);
    }
    SEAM(6);
    if (IN(7)) {
        pg8::Gemm g{(const bf16_t*)(ws + WS_ACT), (const bf16_t*)(ws + WS_WDN0), DFF, 0}; pg8::StaticOrder S; S.init(96, 4, G, blockIdx.x, true);
        EpiRes E{Y, Y + (size_t)TP * 1024, Y, mod + 5 * 1024, (const float*)(ws + WS_STAT), p.in[11], p.in[12]};
        pg8::gemm_phase<EpiRes, true>(lds, g, S, E);
    }
    SEAM(7);
    if (IN(8)) phase_ln(p, p.in[11] + 1024, p.in[12] + 1024, mod + 5 * 6144, 0, true, false);
    SEAM(8);
    if (IN(9)) {
        pg8::Gemm g{XA, (const bf16_t*)(ws + WS_WIN), 1024, 0}; pg8::StaticOrder S; S.init(96, 13, G, blockIdx.x);
        EpiIn E{(bf16_t*)(ws + WS_QKPRE), (bf16_t*)(ws + WS_V), (bf16_t*)(ws + WS_OG), (float*)(ws + WS_GATE), p.in[20]};
        pg8::gemm_phase<EpiIn, false, true>(lds, g, S, E);
    }
    SEAM(9);
    if (IN(10)) phase_mlconv(p);
    SEAM(10);
    if (IN(11)) phase_scan(p, lds);
    SEAM(11);
    if (IN(12)) phase_mlout(p);
    SEAM(12);
    if (IN(13)) {
        pg8::Gemm g{XA, (const bf16_t*)(ws + WS_WOUT), 1024, 0}; pg8::StaticOrder S; S.init(96, 4, G, blockIdx.x, false);
        EpiRes E{Y, Y + (size_t)TP * 1024, Y, mod + 5 * 6144 + 2 * 1024, (const float*)(ws + WS_STAT), p.in[11] + 1024, p.in[12] + 1024};
        pg8::gemm_phase<EpiRes, true>(lds, g, S, E);
        tr_idle(p.in[23] + (size_t)1024 * NUP, 1024, NUP, NUP, (bf16_t*)(ws + WS_WUP1), 1, lds, 384 % G);
    }
    SEAM(13);
    if (IN(14)) { phase_ln(p, p.in[11] + 2048, p.in[12] + 2048, mod + 5 * 6144, 3, true, false); }
    SEAM(14);
    if (IN(15)) {
        pg8::Gemm g{XA, (const bf16_t*)(ws + WS_WUP1), 1024, 1}; pg8::StaticOrder S; S.init(100, 22, G, blockIdx.x);
        EpiFFNUp E{(bf16_t*)(ws + WS_ACT), p.in[24] + 3 * NUP, p.in[25] + NUP, (LAS float*)(lds + pg8::STAGE_BYTES)};
        pg8::gemm_phase<EpiFFNUp, false, true>(lds, g, S, E);
        tr_idle(p.in[26] + (size_t)DFF * 1024, DFF, 1024, 1024, (bf16_t*)(ws + WS_WDN1), 0, lds, 2200 % G);
    }
    SEAM(15);
    if (IN(16)) {
        pg8::Gemm g{(const bf16_t*)(ws + WS_ACT), (const bf16_t*)(ws + WS_WDN1), DFF, 0}; pg8::StaticOrder S; S.init(96, 4, G, blockIdx.x, true);
        EpiRes E{Y, Y + (size_t)TP * 1024, Y, mod + 5 * 6144 + 5 * 1024, (const float*)(ws + WS_STAT), p.in[11] + 2048, p.in[12] + 2048};
        pg8::gemm_phase<EpiRes, true>(lds, g, S, E);
    }
    SEAM(16);
    if (IN(17)) phase_ln(p, p.in[11] + 3072, p.in[12] + 3072, mod, 0, false, true);
#undef IN
#undef SEAM
}

extern "C" void kernel_launch(void* const* d_in, const int* in_sizes, int n_in, void* d_out, int out_size, void* d_ws, size_t ws_size, hipStream_t stream) {
    static int grid = 0;
    if (grid == 0) {
        if (n_in != 27 || ws_size < WS_END) { fprintf(stderr, "kernel_launch: unexpected n_in %d / ws_size %zu (need %zu)\n", n_in, ws_size, (size_t)WS_END); grid = -1; return; }
        int dev = 0, cus = 0, per_cu = 0;
        hipGetDevice(&dev);
        hipDeviceGetAttribute(&cus, hipDeviceAttributeMultiprocessorCount, dev);
        hipFuncSetAttribute((const void*)fwd_kernel, hipFuncAttributeMaxDynamicSharedMemorySize, LDS_BYTES);
        hipOccupancyMaxActiveBlocksPerMultiprocessor(&per_cu, (const void*)fwd_kernel, NTHREADS, LDS_BYTES);
        if (per_cu < 1) per_cu = 1;
        if (per_cu > 1) per_cu = 1;
        grid = cus * per_cu;
        (void)hipGetLastError();
    }
    if (grid < 0) return;
    if (hipMemsetAsync((char*)d_ws + WS_CTL, 0, 16384, stream) != hipSuccess) { fprintf(stderr, "memset failed\n"); return; }
    Params p{};
    for (int i = 0; i < 27; ++i) p.in[i] = (const float*)d_in[i];
    p.out = (float*)d_out; p.ws = (unsigned char*)d_ws;
#if MULTI_LAUNCH
    for (int ph = 0; ph < NPHASE; ++ph) {
        p.ph_lo = ph; p.ph_hi = ph + 1;
        hipLaunchKernelGGL(fwd_kernel, dim3(grid), dim3(NTHREADS), LDS_BYTES, stream, p);
    }
#else
    p.ph_lo = 0; p.ph_hi = NPHASE;
    void* args[] = {&p};
    hipError_t e = hipLaunchCooperativeKernel((const void*)fwd_kernel, dim3(grid), dim3(NTHREADS), args, LDS_BYTES, stream);
    if (e != hipSuccess) fprintf(stderr, "cooperative launch failed: %s (grid %d)\n", hipGetErrorString(e), grid);
#endif
}
```

```cpp
#include <hip/hip_runtime.h>
#include <hip/hip_cooperative_groups.h>
#include <cstdint>
#include <cstdio>
namespace cg = cooperative_groups;

#ifndef MULTI_LAUNCH
#define MULTI_LAUNCH 0
#endif

#define LAS __attribute__((address_space(3)))
typedef unsigned short bf16_t;
typedef short bf16x8 __attribute__((ext_vector_type(8)));
typedef short bf16x4 __attribute__((ext_vector_type(4)));
typedef float f32x4 __attribute__((ext_vector_type(4)));
typedef float f32x16 __attribute__((ext_vector_type(16)));
typedef unsigned u32x4 __attribute__((ext_vector_type(4)));
typedef unsigned u32x2 __attribute__((ext_vector_type(2)));

constexpr int D = 1024, TP = 8192, TS = 16384, T = 24576, SEQP = 256, SEQS = 4096, LKS = 4352;
constexpr int DFF = 2816, NUP = 5632, NIN = 3088, NINP = 3328;
constexpr float ALPHA = 1.41421356237f, LN_EPS = 1e-5f;
constexpr float QSCALE = 0.125f * 1.44269504089f;
constexpr int NTHREADS = 512;

constexpr size_t WS_CTL = 0;
constexpr size_t WS_WOUT = 16384;
constexpr size_t WS_MOD  = WS_WOUT + (size_t)1024 * 1024 * 2;
constexpr size_t WS_ROPE = WS_MOD + (size_t)2 * 5 * 6144 * 4;
constexpr size_t WS_GATE = WS_ROPE + 8192;
constexpr size_t WS_STAT = WS_GATE + (size_t)T * 16 * 4;
constexpr size_t WS_XA   = WS_STAT + (size_t)T * 2 * 4;
constexpr size_t WS_BIG  = WS_XA + (size_t)(T + 256) * 1024 * 2;
constexpr size_t WS_Q    = WS_BIG;
constexpr size_t WS_KP   = WS_Q + (size_t)T * 1024 * 2;
constexpr size_t WS_VTP  = WS_KP + (size_t)TP * 1024 * 2;
constexpr size_t WS_KS   = WS_VTP + (size_t)TP * 1024 * 2;
constexpr size_t WS_VTS  = WS_KS + (size_t)4 * LKS * 1024 * 2;
constexpr size_t WS_END_ATT = WS_VTS + (size_t)4 * LKS * 1024 * 2;
constexpr size_t WS_ACT  = WS_BIG;
constexpr size_t WS_QKPRE = WS_BIG;
constexpr size_t WS_V     = WS_QKPRE + (size_t)T * 1024 * 2;
constexpr size_t WS_OG    = WS_V + (size_t)T * 1024 * 2;
constexpr size_t WS_TAIL = WS_END_ATT;
constexpr size_t WS_WQKV = WS_TAIL;
constexpr size_t WS_WO   = WS_WQKV + (size_t)3072 * 1024 * 2;
constexpr size_t WS_WIN  = WS_WO + (size_t)1024 * 1024 * 2;
constexpr size_t WS_WUP0 = WS_WIN + (size_t)NINP * 1024 * 2;
constexpr size_t WS_WDN0 = WS_WUP0 + (size_t)NUP * 1024 * 2;
constexpr size_t WS_TAIL_END0 = WS_WDN0 + (size_t)1024 * DFF * 2;
constexpr size_t WS_HB   = WS_TAIL;
constexpr size_t WS_WUP1 = WS_TAIL;
constexpr size_t WS_WDN1 = WS_WUP1 + (size_t)NUP * 1024 * 2;
constexpr size_t WS_END  = WS_TAIL + (size_t)T * 1024 * 2;
static_assert(WS_OG + (size_t)T * 1024 * 2 <= WS_END_ATT && WS_ACT + (size_t)T * DFF * 2 <= WS_END_ATT, "ws map");
static_assert(WS_TAIL_END0 <= WS_END && WS_WDN1 + (size_t)1024 * DFF * 2 <= WS_END, "tail map");
static_assert(WS_END <= (size_t)256 * 1024 * 1024, "workspace over 256 MiB");

constexpr size_t OUT_Y = 0, OUT_K = 25165824, OUT_V = 33554432, OUT_C = 41943040, OUT_N = 50331648, OUT_M = 50364416;

struct Params {
    const float* in[27];
    float* out;
    unsigned char* ws;
    int ph_lo, ph_hi;
};

typedef __bf16 bf16v2_t __attribute__((ext_vector_type(2)));
typedef float f32x2_t __attribute__((ext_vector_type(2)));
__device__ __forceinline__ unsigned cvt_pk_bf16(float lo, float hi) { const f32x2_t v = {lo, hi}; const bf16v2_t b = __builtin_convertvector(v, bf16v2_t); return __builtin_bit_cast(unsigned, b); }
__device__ __forceinline__ bf16_t f2bf(float x) { return (bf16_t)(cvt_pk_bf16(x, 0.f) & 0xffffu); }
__device__ __forceinline__ float bf2f(unsigned v) { return __uint_as_float(v << 16); }
__device__ __forceinline__ float bflo(unsigned v) { return __uint_as_float(v << 16); }
__device__ __forceinline__ float bfhi(unsigned v) { return __uint_as_float(v & 0xffff0000u); }
__device__ __forceinline__ float silu_f(float x) { return x * __builtin_amdgcn_rcpf(1.f + __expf(-x)); }
__device__ __forceinline__ float sigmoid_f(float x) { return __builtin_amdgcn_rcpf(1.f + __expf(-x)); }
__device__ __forceinline__ float wave_sum(float v) {
#pragma unroll
    for (int o = 1; o < 64; o <<= 1) v += __shfl_xor(v, o);
    return v;
}
__device__ __forceinline__ int mod_group(int row) { return row < TP ? 0 : 1 + ((row - TP) >> 12); }

namespace pg8 {
constexpr int BM = 256, BK = 64, HALF = 128, HTB = HALF * BK * 2, STAGE_BYTES = 8 * HTB, NXCD = 8, WGM = 8;
__host__ __device__ __forceinline__ int lds_byte(int r, int c) { const int st = (r >> 4) * 2 + (c >> 5), rr = r & 15, cc = c & 31, ob = rr * 64 + cc * 2; return st * 1024 + (ob ^ (((ob >> 9) & 1) << 5)); }
__host__ __device__ __forceinline__ void stage_rc(int b, int& R, int& C) { const int st = b / 1024, sb = b % 1024, swz = sb ^ (((sb >> 9) & 1) << 5); R = (st >> 1) * 16 + swz / 64; C = (st & 1) * 32 + (swz % 64) / 2; }
struct Unit { int pm, pn, nbj, coff; };
struct Gemm { const bf16_t* A; const bf16_t* Bt; int K; int amode; };
__device__ __forceinline__ long a_row0(int amode, int pm) {
    if (amode == 0 || pm < 32) return (long)pm * 256;
    const int s = pm - 32, b = s / 17, t = s - b * 17;
    return (long)TP + b * SEQS + t * 254 - 1;
}
struct StaticOrder {
    int nM, nN, nwg, G, c, nfull;
    __device__ __forceinline__ void init(int nM_, int nN_, int G_, int c_, bool halves = false) { nM = nM_; nN = nN_; nwg = nM * nN; G = G_; c = c_; nfull = nwg;
        if (halves) { const int nf = (nwg / G) * G; if (2 * (nwg - nf) <= G) nfull = nf; } }
    __device__ __forceinline__ bool next(int i, Unit& u) const {
        const long L = (long)i * G + c; u.nbj = 2; u.coff = 0;
        int wgid;
        if (L < nfull) wgid = (int)L;
        else { const long hh = L - nfull; if (hh >= 2L * (nwg - nfull)) return false; wgid = nfull + (int)(hh >> 1); u.nbj = 1; u.coff = (int)(hh & 1) * 128; } { const int q = nwg / NXCD, r = nwg % NXCD, xcd = wgid % NXCD, off = wgid / NXCD; wgid = (xcd < r ? xcd * (q + 1) : r * (q + 1) + (xcd - r) * q) + off; }
        const int nig = WGM * nN, gid = wgid / nig, fm = gid * WGM, gsz = (nM - fm) < WGM ? (nM - fm) : WGM;
        u.pm = fm + ((wgid % nig) % gsz); u.pn = (wgid % nig) / gsz; return true;
    }
};

template <class Epi, bool HALVES = false, bool PERMB = false>
__device__ __forceinline__ void gemm_phase(LAS unsigned char* lds, const Gemm g, const StaticOrder& S, const Epi& E) {
    const int tid = threadIdx.x, wid = __builtin_amdgcn_readfirstlane(tid >> 6), lane = tid & 63, wr = wid >> 2, wc = wid & 3, fr = lane & 15, fq = lane >> 4;
    const int K = g.K, nt = K / BK;
    unsigned voffA[2], voffB[2];
#pragma unroll
    for (int i = 0; i < 2; ++i) { int R, C; stage_rc(tid * 16 + i * 8192, R, C); voffA[i] = (unsigned)(R * K + C) * 2u;
        int Rb = R; if (PERMB) { const int rho = R & 31, n_ = rho >> 4, i_ = rho & 15; Rb = (R & ~31) + 8 * (i_ >> 2) + 4 * n_ + (i_ & 3); }
        voffB[i] = (unsigned)(Rb * K + C) * 2u; }
    const size_t kstep = (size_t)(BK * 2);
    const size_t hstep = (size_t)HALF * K * 2;
    const size_t tstep = 2 * hstep;
    const size_t rstep = (size_t)K * 2;
    const unsigned ldsw = (unsigned)wid * 1024u;
    const int aoff = lds_byte(wr * 64 + fr, fq * 8), boff = lds_byte(wc * 32 + fr, fq * 8);
#define PG8_SA(b, h) (((b) * 2 + (h)) * HTB)
#define PG8_SB(b, h) ((4 + (b) * 2 + (h)) * HTB)
#define PG8_STAGE(bufoff, gbase, voff) do { _Pragma("unroll") for (int _i = 0; _i < 2; ++_i) \
        __builtin_amdgcn_global_load_lds((const unsigned*)((const char*)(gbase) + (voff)[_i]), (LAS unsigned*)(lds + (bufoff) + ldsw + _i * 8192), 16, 0, 0); } while (0)
#define PG8_LDA(dst, b, h) do { _Pragma("unroll") for (int m = 0; m < 4; ++m) _Pragma("unroll") for (int k = 0; k < 2; ++k) dst[m][k] = *(const LAS bf16x8*)(lds + PG8_SA(b, h) + aoff + m * 2048 + k * 1024); } while (0)
#define PG8_LDB(dst, b, h) do { _Pragma("unroll") for (int n = 0; n < 2; ++n) _Pragma("unroll") for (int k = 0; k < 2; ++k) dst[n][k] = *(const LAS bf16x8*)(lds + PG8_SB(b, h) + boff + n * 2048 + k * 1024); } while (0)
#define PG8_MMA(ai, bj, At, Bt) do { __builtin_amdgcn_s_setprio(1); _Pragma("unroll") for (int m = 0; m < 4; ++m) _Pragma("unroll") for (int n = 0; n < 2; ++n) _Pragma("unroll") for (int k = 0; k < 2; ++k) \
        acc[ai][bj][m][n] = __builtin_amdgcn_mfma_f32_16x16x32_bf16(Bt[n][k], At[m][k], acc[ai][bj][m][n], 0, 0, 0); __builtin_amdgcn_s_setprio(0); } while (0)
#define PG8_WAIT_V(n) asm volatile("s_waitcnt vmcnt(" #n ")" ::: "memory")
#define PG8_WAIT_L(n) asm volatile("s_waitcnt lgkmcnt(" #n ")" ::: "memory")
#define PG8_BAR __builtin_amdgcn_s_barrier()
#define PG8_SCHED __builtin_amdgcn_sched_barrier(0)
    Unit cur, nxt; int ui = 0;
    if (!S.next(0, cur)) return;
    f32x4 acc[2][2][4][2];
#pragma unroll
    for (int a = 0; a < 2; ++a)
#pragma unroll
        for (int b = 0; b < 2; ++b)
#pragma unroll
            for (int m = 0; m < 4; ++m)
#pragma unroll
                for (int n = 0; n < 2; ++n) acc[a][b][m][n] = (f32x4){0.f, 0.f, 0.f, 0.f};
    bf16x8 At[4][2], B0[2][2], B1[2][2];
    const char* cA = (const char*)g.A + a_row0(g.amode, cur.pm) * (long)rstep; const char* cB = (const char*)g.Bt + (size_t)cur.pn * tstep + (size_t)cur.coff * rstep;
    size_t cBh = (!HALVES || cur.nbj == 2) ? hstep : 0;
    PG8_STAGE(PG8_SB(0, 0), cB, voffB); PG8_STAGE(PG8_SB(0, 1), cB + cBh, voffB); PG8_STAGE(PG8_SA(0, 0), cA, voffA); PG8_STAGE(PG8_SA(0, 1), cA + hstep, voffA);
    if (wr == 1) PG8_BAR;
    PG8_WAIT_V(2); PG8_BAR;
    PG8_STAGE(PG8_SB(1, 0), cB + kstep, voffB); PG8_STAGE(PG8_SA(1, 0), cA + kstep, voffA); PG8_STAGE(PG8_SB(1, 1), cB + cBh + kstep, voffB);
    PG8_WAIT_V(6); PG8_BAR;
    for (;;) {
        const bool has_next = S.next(ui + 1, nxt);
        const char* nA = has_next ? (const char*)g.A + a_row0(g.amode, nxt.pm) * (long)rstep : cA; const char* nB = has_next ? (const char*)g.Bt + (size_t)nxt.pn * tstep + (size_t)nxt.coff * rstep : cB;
        const size_t nBh = !HALVES ? hstep : (has_next ? (nxt.nbj == 2 ? hstep : 0) : cBh);
        const bool full = !HALVES || cur.nbj == 2;
        if (full) {
        for (int t = 0; t < nt; t += 2) {
            const bool last = (t == nt - 2);
            const char* a1 = cA + (size_t)(t + 1) * kstep;
            const char* a2 = last ? nA : cA + (size_t)(t + 2) * kstep; const char* b2 = last ? nB : cB + (size_t)(t + 2) * kstep;
            const char* a3 = a2 + kstep; const char* b3 = b2 + kstep; const size_t b2h = last ? nBh : cBh;
            PG8_LDB(B0, 0, 0); PG8_LDB(B1, 0, 1); PG8_SCHED; PG8_LDA(At, 0, 0); PG8_STAGE(PG8_SA(1, 1), a1 + hstep, voffA);
            PG8_WAIT_V(8); PG8_WAIT_L(0); PG8_BAR; PG8_MMA(0, 0, At, B0); PG8_MMA(0, 1, At, B1); PG8_BAR; PG8_SCHED;
            PG8_LDA(At, 0, 1); PG8_STAGE(PG8_SB(0, 0), b2, voffB); PG8_STAGE(PG8_SB(0, 1), b2 + b2h, voffB); PG8_STAGE(PG8_SA(0, 0), a2, voffA);
            PG8_WAIT_V(8); PG8_WAIT_L(0); PG8_BAR; PG8_MMA(1, 0, At, B0); PG8_MMA(1, 1, At, B1); PG8_BAR; PG8_SCHED;
            PG8_LDB(B0, 1, 0); PG8_LDB(B1, 1, 1); PG8_SCHED; PG8_LDA(At, 1, 0); PG8_STAGE(PG8_SA(0, 1), a2 + hstep, voffA);
            PG8_WAIT_V(8); PG8_WAIT_L(0); PG8_BAR; PG8_MMA(0, 0, At, B0); PG8_MMA(0, 1, At, B1); PG8_BAR; PG8_SCHED;
            PG8_LDA(At, 1, 1); PG8_STAGE(PG8_SB(1, 0), b3, voffB); PG8_STAGE(PG8_SB(1, 1), b3 + b2h, voffB); PG8_STAGE(PG8_SA(1, 0), a3, voffA);
            PG8_WAIT_V(8); PG8_WAIT_L(0); PG8_BAR; PG8_MMA(1, 0, At, B0); PG8_MMA(1, 1, At, B1); PG8_BAR; PG8_SCHED;
        }
        } else {
        for (int t = 0; t < nt; t += 2) {
            const bool last = (t == nt - 2);
            const char* a1 = cA + (size_t)(t + 1) * kstep;
            const char* a2 = last ? nA : cA + (size_t)(t + 2) * kstep; const char* b2 = last ? nB : cB + (size_t)(t + 2) * kstep;
            const char* a3 = a2 + kstep; const char* b3 = b2 + kstep; const size_t b2h = last ? nBh : cBh;
            PG8_LDB(B0, 0, 0); PG8_LDB(B1, 0, 1); PG8_SCHED; PG8_LDA(At, 0, 0); PG8_STAGE(PG8_SA(1, 1), a1 + hstep, voffA);
            PG8_WAIT_V(8); PG8_WAIT_L(0); PG8_BAR; PG8_MMA(0, 0, At, B0);  PG8_BAR; PG8_SCHED;
            PG8_LDA(At, 0, 1); PG8_STAGE(PG8_SB(0, 0), b2, voffB); PG8_STAGE(PG8_SB(0, 1), b2 + b2h, voffB); PG8_STAGE(PG8_SA(0, 0), a2, voffA);
            PG8_WAIT_V(8); PG8_WAIT_L(0); PG8_BAR; PG8_MMA(1, 0, At, B0);  PG8_BAR; PG8_SCHED;
            PG8_LDB(B0, 1, 0); PG8_LDB(B1, 1, 1); PG8_SCHED; PG8_LDA(At, 1, 0); PG8_STAGE(PG8_SA(0, 1), a2 + hstep, voffA);
            PG8_WAIT_V(8); PG8_WAIT_L(0); PG8_BAR; PG8_MMA(0, 0, At, B0);  PG8_BAR; PG8_SCHED;
            PG8_LDA(At, 1, 1); PG8_STAGE(PG8_SB(1, 0), b3, voffB); PG8_STAGE(PG8_SB(1, 1), b3 + b2h, voffB); PG8_STAGE(PG8_SA(1, 0), a3, voffA);
            PG8_WAIT_V(8); PG8_WAIT_L(0); PG8_BAR; PG8_MMA(1, 0, At, B0);  PG8_BAR; PG8_SCHED;
        }
        }
        if (wr == 0) PG8_BAR;
        E(acc, cur, wr, wc, fr, fq, lane);
        if (!has_next) break;
#pragma unroll
        for (int a = 0; a < 2; ++a)
#pragma unroll
            for (int b = 0; b < 2; ++b)
#pragma unroll
                for (int m = 0; m < 4; ++m)
#pragma unroll
                    for (int n = 0; n < 2; ++n) acc[a][b][m][n] = (f32x4){0.f, 0.f, 0.f, 0.f};
        cur = nxt; cA = nA; cB = nB; cBh = nBh; ++ui;
        if (wr == 1) PG8_BAR;
    }
    PG8_WAIT_V(0);
    PG8_BAR;
#undef PG8_SA
#undef PG8_SB
#undef PG8_STAGE
#undef PG8_LDA
#undef PG8_LDB
#undef PG8_MMA
#undef PG8_WAIT_V
#undef PG8_WAIT_L
#undef PG8_BAR
#undef PG8_SCHED
}
}
using pg8::Unit;

struct EpiQKV {
    bf16_t *Q, *KP, *KS, *VTP, *VTS; float *outK, *outV; const float* rope;
    __device__ __forceinline__ void operator()(f32x4 (&acc)[2][2][4][2], const Unit& u, int wr, int wc, int fr, int fq, int lane) const {
        const int row0 = u.pm * 256 + wr * 64 + fr;
        const int colt = u.pn * 256, sect = colt >> 10, cb = (colt & 1023) + wc * 32 + 4 * fq;
        const bool sample = row0 >= TP;
#pragma unroll
        for (int ai = 0; ai < 2; ++ai)
#pragma unroll
            for (int m = 0; m < 4; ++m) {
                const int row = row0 + ai * 128 + m * 16;
                const int sb = (row - TP) >> 12, pos = (row - TP) & 4095;
#pragma unroll
                for (int bj = 0; bj < 2; ++bj) {
                    f32x4 v0 = acc[ai][bj][m][0], v1 = acc[ai][bj][m][1];
                    const int c0 = cb + bj * 128;
                    if (sect < 2) {
                        if (sample) {
                            const int p = (wc & 1) ? (pos & 63) : (pos >> 6);
                            const f32x4* rp = (const f32x4*)(rope + (p * 16 + 4 * fq) * 2);
                            const f32x4 r0 = rp[0], r1 = rp[1];
                            const float cs[4] = {r0[0], r0[2], r1[0], r1[2]}, sn[4] = {r0[1], r0[3], r1[1], r1[3]};
#pragma unroll
                            for (int i = 0; i < 4; ++i) { const float x1 = v0[i], x2 = v1[i]; v0[i] = x1 * cs[i] - x2 * sn[i]; v1[i] = x2 * cs[i] + x1 * sn[i]; }
                        }
                        if (sect == 0) {
                            v0 = v0 * QSCALE; v1 = v1 * QSCALE;
                            bf16_t* q = Q + (size_t)row * 1024 + c0;
                            *(u32x2*)q = (u32x2){cvt_pk_bf16(v0[0], v0[1]), cvt_pk_bf16(v0[2], v0[3])};
                            *(u32x2*)(q + 16) = (u32x2){cvt_pk_bf16(v1[0], v1[1]), cvt_pk_bf16(v1[2], v1[3])};
                        } else {
                            bf16_t* kp;
                            if (!sample) { float* o = outK + (size_t)row * 1024 + c0; *(f32x4*)o = v0; *(f32x4*)(o + 16) = v1; kp = KP + (size_t)row * 1024 + c0; }
                            else kp = KS + ((size_t)sb * LKS + 256 + pos) * 1024 + c0;
                            *(u32x2*)kp = (u32x2){cvt_pk_bf16(v0[0], v0[1]), cvt_pk_bf16(v0[2], v0[3])};
                            *(u32x2*)(kp + 16) = (u32x2){cvt_pk_bf16(v1[0], v1[1]), cvt_pk_bf16(v1[2], v1[3])};
                        }
                    } else if (!sample) {
                        float* o = outV + (size_t)row * 1024 + c0; *(f32x4*)o = v0; *(f32x4*)(o + 16) = v1;
                    }
                }
            }
        if (sect == 2) {
#pragma unroll
            for (int ai = 0; ai < 2; ++ai)
#pragma unroll
                for (int bj = 0; bj < 2; ++bj) {
                    const int c0 = cb + bj * 128, h = c0 >> 7, dv = c0 & 127;
                    const int rowb = row0 + ai * 128;
                    bf16_t* vt; size_t ld;
                    if (!sample) { vt = VTP + (((size_t)(rowb >> 8) * 8 + h) * 128 + dv) * 256 + (rowb & 255); ld = 256; }
                    else { vt = VTS + (((size_t)((rowb - TP) >> 12) * 8 + h) * 128 + dv) * LKS + 256 + ((rowb - TP) & 4095); ld = LKS; }
#pragma unroll
                    for (int n = 0; n < 2; ++n)
#pragma unroll
                        for (int i = 0; i < 4; ++i)
#pragma unroll
                            for (int m = 0; m < 4; ++m) vt[(size_t)(16 * n + i) * ld + 16 * m] = f2bf(acc[ai][bj][m][n][i]);
                }
        }
    }
};

struct EpiRes {
    const float *xp, *xs;
    float* Y; const float* gate;
    const float *stat, *lg, *lb;
    __device__ __forceinline__ void operator()(f32x4 (&acc)[2][2][4][2], const Unit& u, int wr, int wc, int fr, int fq, int lane) const {
        const int row0 = u.pm * 256 + wr * 64 + fr, c00 = u.pn * 256 + u.coff + wc * 32 + 4 * fq;
        const float* gp = gate + (size_t)mod_group(row0) * 6144 + c00;
#pragma unroll
        for (int bj = 0; bj < 2; ++bj) {
            if (bj == 1 && u.nbj == 1) continue;
            f32x4 gv[2], g4[2], b4[2];
#pragma unroll
            for (int n = 0; n < 2; ++n) {
                const int co = bj * 128 + n * 16;
                gv[n] = *(const f32x4*)(gp + co); g4[n] = (f32x4){1.f, 1.f, 1.f, 1.f}; b4[n] = (f32x4){0.f, 0.f, 0.f, 0.f};
                if (stat) { g4[n] = *(const f32x4*)(lg + c00 + co); b4[n] = *(const f32x4*)(lb + c00 + co); }
            }
#pragma unroll
            for (int ai = 0; ai < 2; ++ai)
#pragma unroll
                for (int m = 0; m < 4; ++m) {
                    const int row = row0 + ai * 128 + m * 16;
                    const float* xr = (row < TP ? xp + (size_t)row * 1024 : xs + (size_t)(row - TP) * 1024) + c00 + bj * 128;
                    float* yr = Y + (size_t)row * 1024 + c00 + bj * 128;
                    f32x4 x0 = *(const f32x4*)xr, x1 = *(const f32x4*)(xr + 16);
                    if (stat) { const float mu = stat[2 * row], rs = stat[2 * row + 1]; x0 = (x0 - mu) * rs * g4[0] + b4[0]; x1 = (x1 - mu) * rs * g4[1] + b4[1]; }
                    *(f32x4*)yr = x0 * ALPHA + gv[0] * acc[ai][bj][m][0];
                    *(f32x4*)(yr + 16) = x1 * ALPHA + gv[1] * acc[ai][bj][m][1];
                }
        }
    }
};

struct EpiFFNUp {
    bf16_t* ACT; const float* cw; const float* cbias;
    LAS float* edge;
    __device__ __forceinline__ void operator()(f32x4 (&acc)[2][2][4][2], const Unit& u, int wr, int wc, int fr, int fq, int lane) const {
        asm volatile("" : "+v"(lane));
        fr = lane & 15; fq = lane >> 4;
        int tok0, pos0, seqlen; bool ovl;
        if (u.pm < 32) { tok0 = u.pm * 256; pos0 = 0; seqlen = 256; ovl = false; }
        else { const int s = u.pm - 32, b = s / 17, t = s - b * 17; pos0 = t * 254 - 1; tok0 = TP + b * SEQS + pos0; seqlen = SEQS; ovl = true; }
        const int rbase = wr * 64 + fr;
#pragma unroll
        for (int ai = 0; ai < 2; ++ai)
#pragma unroll
            for (int m = 0; m < 4; ++m) {
                const int pos = pos0 + ai * 128 + rbase + m * 16;
                if (pos < 0 || pos >= seqlen) {
#pragma unroll
                    for (int bj = 0; bj < 2; ++bj)
#pragma unroll
                        for (int n = 0; n < 2; ++n) acc[ai][bj][m][n] = (f32x4){0.f, 0.f, 0.f, 0.f};
                }
            }
        const int ccol = wc * 32 + 8 * fq;
#pragma unroll
        for (int ai = 0; ai < 2; ++ai) {
            const int rb = ai * 2 + wr;
            if (fr == 0) {
#pragma unroll
                for (int bj = 0; bj < 2; ++bj)
#pragma unroll
                    for (int n = 0; n < 2; ++n) *(LAS f32x4*)(edge + (rb * 2 + 0) * 256 + bj * 128 + n * 4 + ccol) = acc[ai][bj][0][n];
            }
            if (fr == 15) {
#pragma unroll
                for (int bj = 0; bj < 2; ++bj)
#pragma unroll
                    for (int n = 0; n < 2; ++n) *(LAS f32x4*)(edge + (rb * 2 + 1) * 256 + bj * 128 + n * 4 + ccol) = acc[ai][bj][3][n];
            }
        }
        asm volatile("s_waitcnt lgkmcnt(0)" ::: "memory");
        __builtin_amdgcn_s_barrier();
        asm volatile("" ::: "memory");
        const int lp = (lane & 48) | ((fr - 1) & 15), ln = (lane & 48) | ((fr + 1) & 15);
        const int chg = u.pn * 128 + ccol;
#pragma unroll
        for (int bj = 0; bj < 2; ++bj)
#pragma unroll
            for (int n = 0; n < 2; ++n) {
                const int ch = bj * DFF + chg + n * 4;
                const f32x4 w0 = *(const f32x4*)(cw + ch), w1 = *(const f32x4*)(cw + NUP + ch), w2 = *(const f32x4*)(cw + 2 * NUP + ch), bb = *(const f32x4*)(cbias + ch);
#pragma unroll
                for (int ai = 0; ai < 2; ++ai) {
                    const int rb = ai * 2 + wr;
                    f32x4 eprev = (f32x4){0.f, 0.f, 0.f, 0.f}, enext = (f32x4){0.f, 0.f, 0.f, 0.f};
                    if (rb > 0) eprev = *(const LAS f32x4*)(edge + ((rb - 1) * 2 + 1) * 256 + bj * 128 + n * 4 + ccol);
                    if (rb < 3) enext = *(const LAS f32x4*)(edge + ((rb + 1) * 2 + 0) * 256 + bj * 128 + n * 4 + ccol);
#pragma unroll
                    for (int i = 0; i < 4; ++i) {
                        float up[4], dn[4];
#pragma unroll
                        for (int m = 0; m < 4; ++m) { float cv = acc[ai][bj][m][n][i]; asm volatile("" : "+v"(cv)); acc[ai][bj][m][n][i] = cv; const int ci = __builtin_bit_cast(int, cv);
                            up[m] = __builtin_bit_cast(float, __builtin_amdgcn_update_dpp(0, ci, 0x121, 0xf, 0xf, false));
                            dn[m] = __builtin_bit_cast(float, __builtin_amdgcn_update_dpp(0, ci, 0x12F, 0xf, 0xf, false)); }
#pragma unroll
                        for (int m = 0; m < 4; ++m) {
                            const float pv = (fr == 0) ? (m == 0 ? eprev[i] : up[m == 0 ? 0 : m - 1]) : up[m];
                            const float nv = (fr == 15) ? (m == 3 ? enext[i] : dn[m == 3 ? 3 : m + 1]) : dn[m];
                            float rv = w0[i] * pv + w1[i] * acc[ai][bj][m][n][i] + w2[i] * nv + bb[i];
                            asm volatile("" : "+v"(rv));
                            acc[ai][bj][m][n][i] = rv;
                        }
                        __builtin_amdgcn_sched_barrier(0);
                    }
                    asm volatile("" ::: "memory");
                }
            }
#pragma unroll
        for (int ai = 0; ai < 2; ++ai)
#pragma unroll
            for (int m = 0; m < 4; ++m) {
                const int r = ai * 128 + rbase + m * 16, pos = pos0 + r;
                const bool ok = ovl ? (r >= 1 && r <= 254 && pos < seqlen) : true;
                if (ok) {
                    bf16_t* o = ACT + (size_t)(tok0 + r) * DFF + chg;
                    const f32x4 g0 = acc[ai][0][m][0], v0 = acc[ai][1][m][0], g1 = acc[ai][0][m][1], v1 = acc[ai][1][m][1];
                    *(u32x4*)o = (u32x4){cvt_pk_bf16(silu_f(g0[0]) * v0[0], silu_f(g0[1]) * v0[1]), cvt_pk_bf16(silu_f(g0[2]) * v0[2], silu_f(g0[3]) * v0[3]),
                                         cvt_pk_bf16(silu_f(g1[0]) * v1[0], silu_f(g1[1]) * v1[1]), cvt_pk_bf16(silu_f(g1[2]) * v1[2], silu_f(g1[3]) * v1[3])};
                }
            }
    }
};

struct EpiIn {
    bf16_t *QKPRE, *V, *OG; float* GT; const float* bgate;
    __device__ __forceinline__ void operator()(f32x4 (&acc)[2][2][4][2], const Unit& u, int wr, int wc, int fr, int fq, int lane) const {
        const int row0 = u.pm * 256 + wr * 64 + fr;
        const int colt = u.pn * 256, sect = colt >> 10, cb = (colt & 1023) + wc * 32 + 8 * fq;
        if (sect < 3) {
            bf16_t* dst = QKPRE + (size_t)sect * ((size_t)T * 1024);
#pragma unroll
            for (int ai = 0; ai < 2; ++ai)
#pragma unroll
                for (int m = 0; m < 4; ++m) {
                    bf16_t* o = dst + (size_t)(row0 + ai * 128 + m * 16) * 1024 + cb;
#pragma unroll
                    for (int bj = 0; bj < 2; ++bj) {
                        f32x4 v0 = acc[ai][bj][m][0], v1 = acc[ai][bj][m][1];
                        if (sect == 2) {
#pragma unroll
                            for (int i = 0; i < 4; ++i) { v0[i] = sigmoid_f(v0[i]); v1[i] = sigmoid_f(v1[i]); }
                        }
                        *(u32x4*)(o + bj * 128) = (u32x4){cvt_pk_bf16(v0[0], v0[1]), cvt_pk_bf16(v0[2], v0[3]), cvt_pk_bf16(v1[0], v1[1]), cvt_pk_bf16(v1[2], v1[3])};
                    }
                }
        } else if (wc == 0 && fq < 2) {
            const f32x4 bg0 = *(const f32x4*)(bgate + 8 * fq), bg1 = *(const f32x4*)(bgate + 8 * fq + 4);
#pragma unroll
            for (int ai = 0; ai < 2; ++ai)
#pragma unroll
                for (int m = 0; m < 4; ++m) {
                    const f32x4 vi = acc[ai][0][m][0] + bg0;
                    f32x4 vf = acc[ai][0][m][1] + bg1;
#pragma unroll
                    for (int i = 0; i < 4; ++i) vf[i] = fminf(vf[i], 0.f) - log1pf(__expf(-fabsf(vf[i])));
                    float* gp = GT + (size_t)(row0 + ai * 128 + m * 16) * 16 + 8 * fq;
                    *(f32x4*)gp = vi; *(f32x4*)(gp + 4) = vf;
                }
        }
    }
};

__device__ __forceinline__ void transpose_tile(const float* W, int K, int N, bf16_t* WT, int k0, int n0out, int n0src, LAS float* scr, bool active) {
    const int t = threadIdx.x & 255;
    if (active) {
        const int n = t & 63, kk = t >> 6;
        const bool ok = (n0src >= 0) && (n0src + n < N);
#pragma unroll
        for (int j = 0; j < 16; ++j) { const int k = kk + 4 * j; scr[k * 65 + n] = ok ? W[(size_t)(k0 + k) * N + n0src + n] : 0.f; }
    }
    __syncthreads();
    if (active) {
        const int n = t >> 2, kc2 = t & 3;
#pragma unroll
        for (int c2 = 0; c2 < 2; ++c2) {
            const int kc = kc2 + 4 * c2;
            const LAS float* s = scr + (kc * 8) * 65 + n;
            u32x4 o; o.x = cvt_pk_bf16(s[0], s[65]); o.y = cvt_pk_bf16(s[2 * 65], s[3 * 65]); o.z = cvt_pk_bf16(s[4 * 65], s[5 * 65]); o.w = cvt_pk_bf16(s[6 * 65], s[7 * 65]);
            *(u32x4*)(WT + (size_t)(n0out + n) * K + k0 + kc * 8) = o;
        }
    }
    __syncthreads();
}
__device__ __forceinline__ void transpose_job(const float* W, int K, int N, int Nout, bf16_t* WT, int perm_up, int base, int nit, LAS float* scr0) {
    const int half = threadIdx.x >> 8, item = base + half;
    const bool active = item < nit;
    const int nblk = Nout / 64, it_ = active ? item : 0, kb = it_ / nblk, nb = it_ % nblk;
    int n0src = nb * 64;
    if (perm_up) { const int pn = nb >> 2, j = (nb & 3) * 64; n0src = (j < 128) ? 128 * pn + j : DFF + 128 * pn + (j - 128); }
    transpose_tile(W, K, N, WT, kb * 64, nb * 64, n0src, scr0 + half * (64 * 65), active);
}

__device__ __forceinline__ void phase_prep(const Params& p, LAS unsigned char* lds) {
    LAS float* scr = (LAS float*)lds;
    const int G = gridDim.x, tid = threadIdx.x;
    unsigned char* ws = p.ws;
    constexpr int I_QKV = 16 * 48, I_O = 16 * 16;
    for (int it = 2 * blockIdx.x; it < I_QKV; it += 2 * G) {
        transpose_job(p.in[13], 1024, 3072, 3072, (bf16_t*)(ws + WS_WQKV), 0, it, I_QKV, scr);
    }
    __syncthreads();
    {
        LAS float* cond = (LAS float*)lds;
        LAS float* red = cond + 5 * 1024;
        for (int i = tid; i < 5 * 1024; i += NTHREADS) { const int g = i >> 10, k = i & 1023; const float c = g == 0 ? p.in[8][k] : p.in[2][(g - 1) * 1024 + k]; cond[i] = silu_f(c); }
        __syncthreads();
        for (int it = (G - 1 - (int)blockIdx.x); it < 192; it += G) {
            const int l = it / 96, cb = it % 96, c4 = (tid & 15) * 4, kc = tid >> 4;
            const float* w = p.in[9] + (size_t)l * 1024 * 6144 + cb * 64 + c4;
            f32x4 a0 = (f32x4){0.f, 0.f, 0.f, 0.f}, a1 = a0, a2 = a0, a3 = a0, a4 = a0;
#pragma unroll 8
            for (int k = kc * 32; k < kc * 32 + 32; ++k) {
                const f32x4 wv = *(const f32x4*)(w + (size_t)k * 6144);
                a0 += wv * cond[k]; a1 += wv * cond[1024 + k]; a2 += wv * cond[2048 + k]; a3 += wv * cond[3072 + k]; a4 += wv * cond[4096 + k];
            }
            *(LAS f32x4*)(red + (kc * 5 + 0) * 64 + c4) = a0; *(LAS f32x4*)(red + (kc * 5 + 1) * 64 + c4) = a1; *(LAS f32x4*)(red + (kc * 5 + 2) * 64 + c4) = a2;
            *(LAS f32x4*)(red + (kc * 5 + 3) * 64 + c4) = a3; *(LAS f32x4*)(red + (kc * 5 + 4) * 64 + c4) = a4;
            __syncthreads();
            for (int o = tid; o < 320; o += NTHREADS) {
                const int g = o >> 6, c = o & 63;
                float s = 0.f;
#pragma unroll 8
                for (int q = 0; q < 32; ++q) s += red[(q * 5 + g) * 64 + c];
                ((float*)(ws + WS_MOD))[((size_t)l * 5 + g) * 6144 + cb * 64 + c] = s + p.in[10][(size_t)l * 6144 + cb * 64 + c];
            }
            __syncthreads();
        }
    }
    const int gt = blockIdx.x * NTHREADS + tid, NGT = G * NTHREADS;
    {
        bf16_t* KS = (bf16_t*)(ws + WS_KS); bf16_t* VTS = (bf16_t*)(ws + WS_VTS);
        for (int i = gt; i < 4 * 256 * 1024 / 4; i += NGT) {
            const int e = i * 4, b = e >> 18, rc = e & 262143;
            const f32x4 v = *(const f32x4*)(p.in[3] + e);
            *(u32x2*)(KS + (size_t)b * LKS * 1024 + rc) = (u32x2){cvt_pk_bf16(v[0], v[1]), cvt_pk_bf16(v[2], v[3])};
        }
        for (int i = gt; i < 4 * 8 * 128 * 256; i += NGT) {
            const int r = i & 255, dv = (i >> 8) & 127, h = (i >> 15) & 7, b = i >> 18;
            VTS[(((size_t)b * 8 + h) * 128 + dv) * LKS + r] = f2bf(p.in[4][(((size_t)b * 256 + r) * 8 + h) * 128 + dv]);
        }
        if (gt < 1024) {
            const int pos = gt >> 4, f = gt & 15;
            const float inv = exp2f(-(float)f * (13.287712379549449f / 16.f));
            const float ang = (float)pos * inv;
            const double rev = (double)ang * 0.15915494309189535;
            const float fr = (float)(rev - floor(rev));
            float* rp = (float*)(ws + WS_ROPE);
            rp[gt * 2] = __builtin_amdgcn_cosf(fr); rp[gt * 2 + 1] = __builtin_amdgcn_sinf(fr);
        }
    }
}

__device__ __forceinline__ void tr_idle(const float* W, int K, int N, int Nout, bf16_t* WT, int perm, LAS unsigned char* lds, int first) {
    const int G = gridDim.x;
    if ((int)blockIdx.x < first) return;
    const int nit = (K / 64) * (Nout / 64);
    for (int it = 2 * ((int)blockIdx.x - first); it < nit; it += 2 * (G - first)) transpose_job(W, K, N, Nout, WT, perm, it, nit, (LAS float*)lds);
}
__device__ __forceinline__ void phase_modulate_in(const Params& p) {
    const int lane = threadIdx.x & 63, gw = blockIdx.x * 8 + (threadIdx.x >> 6), NGW = gridDim.x * 8;
    const float* mod = (const float*)(p.ws + WS_MOD);
    bf16_t* XA = (bf16_t*)(p.ws + WS_XA);
    for (int row = gw; row < T; row += NGW) {
        const float* xr = row < TP ? p.in[0] + (size_t)row * 1024 : p.in[1] + (size_t)(row - TP) * 1024;
        const float* mg = mod + (size_t)mod_group(row) * 6144;
#pragma unroll
        for (int j = 0; j < 4; ++j) {
            const int c = 4 * lane + 256 * j;
            const f32x4 x = *(const f32x4*)(xr + c), sh = *(const f32x4*)(mg + c), sc = *(const f32x4*)(mg + 1024 + c);
            const f32x4 h = x * (sc + 1.f) + sh;
            *(u32x2*)(XA + (size_t)row * 1024 + c) = (u32x2){cvt_pk_bf16(h[0], h[1]), cvt_pk_bf16(h[2], h[3])};
        }
    }
}
__device__ __forceinline__ void phase_ln(const Params& p, const float* g, const float* b, const float* modl, int shift_chunk, bool write_h, bool write_y) {
    const int lane = threadIdx.x & 63, gw = blockIdx.x * 8 + (threadIdx.x >> 6), NGW = gridDim.x * 8;
    float* Y = p.out + OUT_Y; bf16_t* XA = (bf16_t*)(p.ws + WS_XA);
    f32x4 gv_[4], bv_[4];
#pragma unroll
    for (int j = 0; j < 4; ++j) { gv_[j] = *(const f32x4*)(g + 4 * lane + 256 * j); bv_[j] = *(const f32x4*)(b + 4 * lane + 256 * j); }
    for (int row = gw; row < T; row += NGW) {
        float* yr = Y + (size_t)row * 1024;
        f32x4 v[4]; float s = 0.f;
#pragma unroll
        for (int j = 0; j < 4; ++j) { v[j] = *(const f32x4*)(yr + 4 * lane + 256 * j); s += (v[j][0] + v[j][1]) + (v[j][2] + v[j][3]); }
        const float mean = wave_sum(s) * (1.f / 1024.f); float s2 = 0.f;
#pragma unroll
        for (int j = 0; j < 4; ++j) { v[j] = v[j] - mean; s2 += (v[j][0] * v[j][0] + v[j][1] * v[j][1]) + (v[j][2] * v[j][2] + v[j][3] * v[j][3]); }
        const float rstd = 1.f / sqrtf(wave_sum(s2) * (1.f / 1024.f) + LN_EPS);
        const float* mg = modl + (size_t)mod_group(row) * 6144 + shift_chunk * 1024;
        if (!write_y && lane == 0) { float* st = (float*)(p.ws + WS_STAT) + 2 * row; st[0] = mean; st[1] = rstd; }
#pragma unroll
        for (int j = 0; j < 4; ++j) {
            const int c = 4 * lane + 256 * j;
            const f32x4 x = v[j] * rstd * gv_[j] + bv_[j];
            if (write_y) *(f32x4*)(yr + c) = x;
            if (write_h) {
                const f32x4 sh = *(const f32x4*)(mg + c), sc = *(const f32x4*)(mg + 1024 + c);
                const f32x4 h = x * (sc + 1.f) + sh;
                *(u32x2*)(XA + (size_t)row * 1024 + c) = (u32x2){cvt_pk_bf16(h[0], h[1]), cvt_pk_bf16(h[2], h[3])};
            }
        }
    }
}
__device__ __forceinline__ void phase_mlconv(const Params& p) {
    const int gt = blockIdx.x * NTHREADS + threadIdx.x, NGT = gridDim.x * NTHREADS;
    const bf16_t* PRE = (const bf16_t*)(p.ws + WS_QKPRE); bf16_t* QK = (bf16_t*)(p.ws + WS_XA);
    const float* cw = p.in[18]; const float* cbv = p.in[19];
    const bool fixed_c = (NGT & 127) == 0;
    const int c_fix = (gt & 127) * 8;
    float w0[8], w1[8], w2[8], bb[8];
#pragma unroll
    for (int j = 0; j < 8; ++j) { w0[j] = cw[c_fix + j]; w1[j] = cw[1024 + c_fix + j]; w2[j] = cw[2048 + c_fix + j]; bb[j] = cbv[c_fix + j]; }
    for (int i = gt; i < T * 128; i += NGT) {
        const int row = i >> 7, c = (i & 127) * 8;
        if (!fixed_c) {
#pragma unroll
            for (int j = 0; j < 8; ++j) { w0[j] = cw[c + j]; w1[j] = cw[1024 + c + j]; w2[j] = cw[2048 + c + j]; bb[j] = cbv[c + j]; }
        }
        int pos, L; if (row < TP) { pos = row & 255; L = 256; } else { pos = (row - TP) & 4095; L = 4096; }
        const u32x4 z = (u32x4){0u, 0u, 0u, 0u};
        const u32x4 x1 = *(const u32x4*)(PRE + (size_t)row * 1024 + c);
        const u32x4 x0 = pos > 0 ? *(const u32x4*)(PRE + (size_t)(row - 1) * 1024 + c) : z;
        const u32x4 x2 = pos < L - 1 ? *(const u32x4*)(PRE + (size_t)(row + 1) * 1024 + c) : z;
        const float sc = c >= 512 ? 0.08838834764831845f : 1.f;
        float o[8];
#pragma unroll
        for (int j = 0; j < 4; ++j) {
            const float u0 = w0[2 * j] * bflo(x0[j]) + w1[2 * j] * bflo(x1[j]) + w2[2 * j] * bflo(x2[j]) + bb[2 * j];
            const float u1 = w0[2 * j + 1] * bfhi(x0[j]) + w1[2 * j + 1] * bfhi(x1[j]) + w2[2 * j + 1] * bfhi(x2[j]) + bb[2 * j + 1];
            o[2 * j] = silu_f(u0) * sc; o[2 * j + 1] = silu_f(u1) * sc;
        }
        *(u32x4*)(QK + (size_t)row * 1024 + c) = (u32x4){cvt_pk_bf16(o[0], o[1]), cvt_pk_bf16(o[2], o[3]), cvt_pk_bf16(o[4], o[5]), cvt_pk_bf16(o[6], o[7])};
    }
}
__device__ __forceinline__ void phase_mlout(const Params& p) {
    const int lane = threadIdx.x & 63, gw = blockIdx.x * 8 + (threadIdx.x >> 6), NGW = gridDim.x * 8;
    const bf16_t* H = (const bf16_t*)(p.ws + WS_QKPRE); const bf16_t* HBk = (const bf16_t*)(p.ws + WS_HB); const bf16_t* OG = (const bf16_t*)(p.ws + WS_OG); bf16_t* HN = (bf16_t*)(p.ws + WS_XA);
    const float* nw = p.in[21];
    float nwv[16];
#pragma unroll
    for (int j = 0; j < 16; ++j) nwv[j] = nw[lane * 16 + j];
    for (int row = gw; row < T; row += NGW) {
        const int c = lane * 16;
        const size_t hoff = ((size_t)(lane >> 2) * T + row) * 64 + (lane & 3) * 16;
        const u32x4 h0 = *(const u32x4*)(H + hoff), h1 = *(const u32x4*)(H + hoff + 8);
        const u32x4 b0 = *(const u32x4*)(HBk + hoff), b1 = *(const u32x4*)(HBk + hoff + 8);
        const u32x4 g0 = *(const u32x4*)(OG + (size_t)row * 1024 + c), g1 = *(const u32x4*)(OG + (size_t)row * 1024 + c + 8);
        float x[16], og[16]; float s = 0.f;
#pragma unroll
        for (int j = 0; j < 4; ++j) { x[2 * j] = bflo(h0[j]) + bflo(b0[j]); x[2 * j + 1] = bfhi(h0[j]) + bfhi(b0[j]); x[8 + 2 * j] = bflo(h1[j]) + bflo(b1[j]); x[8 + 2 * j + 1] = bfhi(h1[j]) + bfhi(b1[j]);
            og[2 * j] = bflo(g0[j]); og[2 * j + 1] = bfhi(g0[j]); og[8 + 2 * j] = bflo(g1[j]); og[8 + 2 * j + 1] = bfhi(g1[j]); }
#pragma unroll
        for (int j = 0; j < 16; ++j) s += x[j];
        s += __shfl_xor(s, 1); s += __shfl_xor(s, 2); s += __shfl_xor(s, 4); s += __shfl_xor(s, 8);
        const float mean = s * (1.f / 256.f); float s2 = 0.f;
#pragma unroll
        for (int j = 0; j < 16; ++j) { x[j] -= mean; s2 += x[j] * x[j]; }
        s2 += __shfl_xor(s2, 1); s2 += __shfl_xor(s2, 2); s2 += __shfl_xor(s2, 4); s2 += __shfl_xor(s2, 8);
        const float rstd = 1.f / sqrtf(s2 * (1.f / 256.f) + LN_EPS);
        unsigned o[8];
#pragma unroll
        for (int j = 0; j < 8; ++j) o[j] = cvt_pk_bf16(x[2 * j] * rstd * nwv[2 * j] * og[2 * j], x[2 * j + 1] * rstd * nwv[2 * j + 1] * og[2 * j + 1]);
        *(u32x4*)(HN + (size_t)row * 1024 + c) = (u32x4){o[0], o[1], o[2], o[3]};
        *(u32x4*)(HN + (size_t)row * 1024 + c + 8) = (u32x4){o[4], o[5], o[6], o[7]};
    }
}

constexpr int AT_KSTR = 136, AT_VSTR = 72;
constexpr int AT_KBYTES = 64 * AT_KSTR * 2, AT_VBYTES = 128 * AT_VSTR * 2, AT_BUF = AT_KBYTES + AT_VBYTES;
__device__ __forceinline__ void phase_attn(const Params& p, LAS unsigned char* lds) {
    const int tid = threadIdx.x, lane = tid & 63, w = tid >> 6, mp = w >> 2, qsub = w & 3, l31 = lane & 31, hh = lane >> 5;
    const int G = gridDim.x;
    const int vb = (G % 8 == 0) ? ((int)blockIdx.x % 8) * (G / 8) + (int)blockIdx.x / 8 : (int)blockIdx.x;
    const bf16_t* Q = (const bf16_t*)(p.ws + WS_Q);
    bf16_t* AO = (bf16_t*)(p.ws + WS_XA);
    float lam;
    {
        const float* dl = p.in[14];
        const float s01 = wave_sum(dl[lane] * dl[64 + lane]), s23 = wave_sum(dl[128 + lane] * dl[192 + lane]);
        lam = __expf(s01) - __expf(s23) + 0.2f;
    }
    const float* subln = p.in[15];
    for (int it = vb; it < 1536; it += G) {
        int Lk, qrow0, h; const bf16_t* Kb; const bf16_t* Vb;
        if (it < 1024) { const int b = it >> 8; h = (it >> 5) & 7; const int qt = it & 31; Lk = LKS; qrow0 = TP + b * SEQS + qt * 128;
            Kb = (const bf16_t*)(p.ws + WS_KS) + (size_t)b * LKS * 1024 + h * 128; Vb = (const bf16_t*)(p.ws + WS_VTS) + ((size_t)b * 8 + h) * 128 * LKS; }
        else { const int j = it - 1024, s = j >> 4; h = (j >> 1) & 7; const int qt = j & 1; Lk = 256; qrow0 = s * 256 + qt * 128;
            Kb = (const bf16_t*)(p.ws + WS_KP) + (size_t)s * 256 * 1024 + h * 128; Vb = (const bf16_t*)(p.ws + WS_VTP) + ((size_t)s * 8 + h) * 128 * 256; }
        const int nkt = Lk >> 6;
        const int qrow = qrow0 + qsub * 32 + l31;
        bf16x8 qf[4];
#pragma unroll
        for (int ks = 0; ks < 4; ++ks) qf[ks] = *(const bf16x8*)(Q + (size_t)qrow * 1024 + h * 128 + mp * 64 + ks * 16 + hh * 8);
        u32x4 kr[2], vr[2];
        const int kkey0 = tid >> 4, kch = tid & 15, vdv0 = tid >> 3, vch = tid & 7;
#define AT_LOAD(kt) do { _Pragma("unroll") for (int i = 0; i < 2; ++i) { \
            kr[i] = *(const u32x4*)(Kb + (size_t)((kt) * 64 + kkey0 + 32 * i) * 1024 + kch * 8); \
            vr[i] = *(const u32x4*)(Vb + (size_t)(vdv0 + 64 * i) * Lk + (kt) * 64 + vch * 8); } } while (0)
#define AT_WRITE(buf) do { _Pragma("unroll") for (int i = 0; i < 2; ++i) { \
            *(LAS u32x4*)(lds + (buf) * AT_BUF + ((kkey0 + 32 * i) * AT_KSTR + kch * 8) * 2) = kr[i]; \
            LAS unsigned char* vw_ = lds + (buf) * AT_BUF + AT_KBYTES + ((vdv0 + 64 * i) * AT_VSTR + (vch >> 1) * 16) * 2 + (vch & 1) * 8; \
            *(LAS u32x2*)vw_ = (u32x2){vr[i].x, vr[i].y}; *(LAS u32x2*)(vw_ + 16) = (u32x2){vr[i].z, vr[i].w}; } } while (0)
        AT_LOAD(0); AT_WRITE(0);
        AT_LOAD(1); AT_WRITE(1);
        __syncthreads();
        f32x16 o[4];
#pragma unroll
        for (int dt = 0; dt < 4; ++dt)
#pragma unroll
            for (int r = 0; r < 16; ++r) o[dt][r] = 0.f;
        float mrun = -1e30f, lsum = 0.f;
        f32x16 s[2], sn[2];
#define AT_QK(dst, buf) do { const LAS unsigned char* kb_ = lds + (buf) * AT_BUF; _Pragma("unroll") for (int kb = 0; kb < 2; ++kb) { \
            _Pragma("unroll") for (int r = 0; r < 16; ++r) dst[kb][r] = 0.f; \
            _Pragma("unroll") for (int ks = 0; ks < 4; ++ks) { \
                const bf16x8 a = *(const LAS bf16x8*)(kb_ + ((kb * 32 + l31) * AT_KSTR + mp * 64 + ks * 16 + hh * 8) * 2); \
                dst[kb] = __builtin_amdgcn_mfma_f32_32x32x16_bf16(a, qf[ks], dst[kb], 0, 0, 0); } } } while (0)
#define AT_SOFTMAX(sv, valid, pdst) do { \
            float mx_ = sv[0][0]; \
            _Pragma("unroll") for (int r = 1; r < 16; ++r) mx_ = fmaxf(mx_, sv[0][r]); \
            _Pragma("unroll") for (int r = 0; r < 16; ++r) mx_ = fmaxf(mx_, sv[1][r]); \
            mx_ = fmaxf(mx_, __shfl_xor(mx_, 32)); \
            const float mnew_ = (valid) ? fmaxf(mrun, mx_) : mrun; \
            alpha = __builtin_amdgcn_exp2f(mrun - mnew_); mrun = mnew_; \
            float ps_ = 0.f; \
            _Pragma("unroll") for (int kb = 0; kb < 2; ++kb) { float pv_[16]; \
                _Pragma("unroll") for (int r = 0; r < 16; ++r) { pv_[r] = __builtin_amdgcn_exp2f(sv[kb][r] - mnew_); ps_ += pv_[r]; } \
                _Pragma("unroll") for (int jj = 0; jj < 2; ++jj) { u32x4 t_; t_.x = cvt_pk_bf16(pv_[8 * jj + 0], pv_[8 * jj + 1]); t_.y = cvt_pk_bf16(pv_[8 * jj + 2], pv_[8 * jj + 3]); \
                    t_.z = cvt_pk_bf16(pv_[8 * jj + 4], pv_[8 * jj + 5]); t_.w = cvt_pk_bf16(pv_[8 * jj + 6], pv_[8 * jj + 7]); pdst[kb * 2 + jj] = __builtin_bit_cast(bf16x8, t_); } } \
            lsum = lsum * alpha + ((valid) ? ps_ : 0.f); } while (0)
#define AT_VLD(dst, dt) do { _Pragma("unroll") for (int g = 0; g < 4; ++g) dst[g] = *(const LAS bf16x8*)(vb_ + (((dt) * 32 + l31) * AT_VSTR + g * 16 + hh * 8) * 2); } while (0)
#define AT_PV(src_, dt) do { _Pragma("unroll") for (int g = 0; g < 4; ++g) o[dt] = __builtin_amdgcn_mfma_f32_32x32x16_bf16(src_[g], pb[g], o[dt], 0, 0, 0); } while (0)
        float alpha = 1.f;
        bf16x8 pb[4], pn[4];
        AT_QK(s, 0);
        AT_SOFTMAX(s, true, pb);
        alpha = 1.f;
        int b0 = 0, b1 = 1, b2 = 2;
        if (w >= 4) __builtin_amdgcn_s_setprio(1);
        for (int kt = 0; kt < nkt; ++kt) {
            const bool has1 = kt + 1 < nkt, has2 = kt + 2 < nkt;
            if (has2) AT_LOAD(kt + 2);
            const LAS unsigned char* vb_ = lds + b0 * AT_BUF + AT_KBYTES;
            if (__builtin_amdgcn_ballot_w64(alpha != 1.f) != 0) {
#pragma unroll
                for (int dt = 0; dt < 4; ++dt) o[dt] = o[dt] * alpha;
            }
            bf16x8 vA[4], vB[4];
            AT_VLD(vA, 0);
            AT_QK(sn, b1);
            AT_VLD(vB, 1); AT_PV(vA, 0);
            AT_VLD(vA, 2); AT_PV(vB, 1);
            AT_VLD(vB, 3); AT_PV(vA, 2);
            AT_PV(vB, 3);
            AT_SOFTMAX(sn, has1, pn);
#pragma unroll
            for (int g = 0; g < 4; ++g) pb[g] = pn[g];
            if (has2) AT_WRITE(b2);
            __syncthreads();
            { const int t_ = b0; b0 = b1; b1 = b2; b2 = t_; }
        }
        __builtin_amdgcn_s_setprio(0);
#undef AT_SOFTMAX
#undef AT_VLD
#undef AT_PV
#undef AT_QK
#undef AT_LOAD
#undef AT_WRITE
        const float ltot = lsum + __shfl_xor(lsum, 32), inv = 1.f / ltot;
        LAS float* X = (LAS float*)lds;
        if (mp == 1) {
#pragma unroll
            for (int dt = 0; dt < 4; ++dt)
#pragma unroll
                for (int r = 0; r < 16; ++r) X[(qsub * 64 + dt * 16 + r) * 64 + lane] = o[dt][r] * inv;
        }
        __syncthreads();
        if (mp == 0) {
            float ss = 0.f;
#pragma unroll
            for (int dt = 0; dt < 4; ++dt)
#pragma unroll
                for (int r = 0; r < 16; ++r) { const float v = o[dt][r] * inv - lam * X[(qsub * 64 + dt * 16 + r) * 64 + lane]; o[dt][r] = v; ss += v * v; }
            ss += __shfl_xor(ss, 32);
            const float rms = 0.8f / sqrtf(ss * (1.f / 128.f) + LN_EPS);
            bf16_t* orow = AO + (size_t)qrow * 1024 + h * 128;
#pragma unroll
            for (int dt = 0; dt < 4; ++dt)
#pragma unroll
                for (int r4 = 0; r4 < 4; ++r4) {
                    const int dv = dt * 32 + r4 * 8 + hh * 4;
                    const f32x4 sw = *(const f32x4*)(subln + dv);
                    *(u32x2*)(orow + dv) = (u32x2){cvt_pk_bf16(o[dt][4 * r4] * rms * sw[0], o[dt][4 * r4 + 1] * rms * sw[1]), cvt_pk_bf16(o[dt][4 * r4 + 2] * rms * sw[2], o[dt][4 * r4 + 3] * rms * sw[3])};
                }
        }
        __syncthreads();
    }
}

constexpr int SC_QSTR = 136, SC_TSTR = 72, SC_NSTR = 84, SC_DVS = 64, SC_NT = SC_DVS / 16 + 1, SC_ER = SC_NT * 16;
constexpr int SC_QS = 0, SC_KS = SC_QS + 64 * SC_QSTR * 2, SC_KT = SC_KS + 64 * SC_QSTR * 2, SC_VT = SC_KT + 128 * SC_TSTR * 2, SC_VTW = SC_VT + SC_ER * SC_TSTR * 2,
              SC_SS = SC_VTW + SC_ER * SC_TSTR * 2, SC_CT = SC_SS + 64 * SC_TSTR * 2, SC_NM = SC_CT + SC_ER * SC_QSTR * 2, SC_GA = SC_NM + 64 * SC_NSTR * 4, SC_END = SC_GA + 6 * 256 + 64;
static_assert(SC_END <= 131072, "scan LDS");
__device__ __forceinline__ void phase_scan(const Params& p, LAS unsigned char* lds) {
    const int tid = threadIdx.x, lane = tid & 63, w = tid >> 6, l15 = lane & 15, lq = lane >> 4;
    const int G = gridDim.x;
    const bf16_t* QK = (const bf16_t*)(p.ws + WS_XA); const bf16_t* Vg = (const bf16_t*)(p.ws + WS_V);
    const float* GT = (const float*)(p.ws + WS_GATE);
    LAS bf16_t* Qs = (LAS bf16_t*)(lds + SC_QS); LAS bf16_t* Ks = (LAS bf16_t*)(lds + SC_KS); LAS bf16_t* Kt = (LAS bf16_t*)(lds + SC_KT);
    LAS bf16_t* Vt = (LAS bf16_t*)(lds + SC_VT); LAS bf16_t* Vtw = (LAS bf16_t*)(lds + SC_VTW); LAS bf16_t* Ss = (LAS bf16_t*)(lds + SC_SS);
    LAS bf16_t* Ct = (LAS bf16_t*)(lds + SC_CT); LAS float* Nm = (LAS float*)(lds + SC_NM);
    LAS bf16_t* Vs = (LAS bf16_t*)(lds + SC_NM);
    LAS float* ga = (LAS float*)(lds + SC_GA); LAS float* gM = ga + 64; LAS float* gb = ga + 128; LAS float* gwi = ga + 192; LAS float* gws = ga + 256; LAS float* gsc = ga + 320;
    for (int i = tid; i < 16 * 64; i += NTHREADS) { const int r = SC_DVS + (i >> 6), c = i & 63; Vt[r * SC_TSTR + c] = (r == SC_DVS) ? (bf16_t)0x3F80 : (bf16_t)0; Vtw[r * SC_TSTR + c] = 0; }
    __syncthreads();
    int it0, itstep, itlim;
    if (G >= 256) { if (blockIdx.x < 128) { it0 = blockIdx.x; itstep = 1 << 20; itlim = 128; } else { it0 = 128 + ((int)blockIdx.x - 128); itstep = G - 128; itlim = 1152; } }
    else { it0 = blockIdx.x; itstep = G; itlim = 1152; }
    for (int it = it0; it < itlim; it += itstep) {
        int seqbase, L, h, sl, sidx, dir; bool samp;
        if (it < 128) { samp = true; dir = it >> 6; const int i2 = it & 63; sidx = i2 >> 4; h = (i2 >> 2) & 3; sl = i2 & 3; seqbase = TP + sidx * SEQS; L = SEQS; }
        else { const int j0 = it - 128; dir = j0 >> 9; const int j = j0 & 511; samp = false; sidx = j >> 4; h = (j >> 2) & 3; sl = j & 3; seqbase = sidx * 256; L = 256; }
        bf16_t* H = (bf16_t*)(p.ws + (dir ? WS_HB : WS_QKPRE));
        const int nch = L >> 6;
        f32x4 cst[SC_NT]; float mst;
        if (samp) {
            const size_t sb = (((size_t)sidx * 2 + dir) * 4 + h) * 128;
#pragma unroll
            for (int nt = 0; nt < SC_NT - 1; ++nt)
#pragma unroll
                for (int j = 0; j < 4; ++j) cst[nt][j] = p.in[5][(sb + 16 * w + 4 * lq + j) * 256 + sl * SC_DVS + nt * 16 + l15];
#pragma unroll
            for (int j = 0; j < 4; ++j) cst[SC_NT - 1][j] = (l15 == 0) ? p.in[6][sb + 16 * w + 4 * lq + j] : 0.f;
            mst = p.in[7][((size_t)sidx * 2 + dir) * 4 + h];
        } else {
#pragma unroll
            for (int nt = 0; nt < SC_NT; ++nt) cst[nt] = (f32x4){0.f, 0.f, 0.f, 0.f};
            mst = 0.f;
        }
#pragma unroll
        for (int nt = 0; nt < SC_NT; ++nt)
            *(LAS u32x2*)(Ct + (nt * 16 + l15) * SC_QSTR + 16 * w + 4 * lq) = (u32x2){cvt_pk_bf16(cst[nt][0], cst[nt][1]), cvt_pk_bf16(cst[nt][2], cst[nt][3])};
#define SC_TOKC(cc, t) (seqbase + (dir ? (L - 1 - ((cc) * 64 + (t))) : ((cc) * 64 + (t))))
        u32x4 qr[2], kr[2], vr = (u32x4){0u, 0u, 0u, 0u}; float ig_r = 0.f, lf_r = 0.f;
#define SC_LOAD(cc) do { _Pragma("unroll") for (int i = 0; i < 2; ++i) { const int id_ = tid + 512 * i; const size_t g = (size_t)SC_TOKC(cc, id_ >> 4) * 1024 + h * 128 + (id_ & 15) * 8; \
                qr[i] = *(const u32x4*)(QK + g); kr[i] = *(const u32x4*)(QK + g + 512); } \
            vr = *(const u32x4*)(Vg + (size_t)SC_TOKC(cc, tid >> 3) * 1024 + h * 256 + sl * SC_DVS + (tid & 7) * 8); \
            if (w == 0) { const size_t gi = (size_t)SC_TOKC(cc, lane) * 16 + dir * 8 + h; ig_r = GT[gi]; lf_r = GT[gi + 4]; } } while (0)
        SC_LOAD(0);
        for (int c = 0; c < nch; ++c) {
#define SC_TOK(t) SC_TOKC(c, t)
            if (w == 0) {
                const float ig = ig_r, lf = lf_r;
                float b = lf;
#pragma unroll
                for (int o = 1; o < 64; o <<= 1) { const float t = __shfl_up(b, o); if (lane >= o) b += t; }
                const float a = ig - b;
                float cm = a;
#pragma unroll
                for (int o = 1; o < 64; o <<= 1) { const float t = __shfl_up(cm, o); if (lane >= o) cm = fmaxf(cm, t); }
                const float Mt = fmaxf(mst, cm);
                const float M63 = __shfl(Mt, 63), bl = __shfl(b, 63);
                ga[lane] = a; gM[lane] = Mt; gb[lane] = b; gwi[lane] = __expf(mst - Mt); gws[lane] = __expf(a - M63);
                if (lane == 0) { gsc[0] = bl + M63; gsc[1] = __expf(mst - M63); }
            }
#pragma unroll
            for (int i = 0; i < 2; ++i) { const int id_ = tid + 512 * i, r = id_ >> 4, ch = id_ & 15;
                *(LAS u32x4*)(Qs + r * SC_QSTR + ch * 8) = qr[i]; *(LAS u32x4*)(Ks + r * SC_QSTR + ch * 8) = kr[i]; }
            *(LAS u32x4*)(Vs + (tid >> 3) * SC_TSTR + (tid & 7) * 8) = vr;
            __syncthreads();
#pragma unroll
            for (int i = 0; i < 2; ++i) { const int r = lane, ch = 2 * w + i; const u32x4 kv = *(const LAS u32x4*)(Ks + r * SC_QSTR + ch * 8);
#pragma unroll
                for (int j = 0; j < 4; ++j) { Kt[(ch * 8 + 2 * j) * SC_TSTR + r] = (bf16_t)(kv[j] & 0xffffu); Kt[(ch * 8 + 2 * j + 1) * SC_TSTR + r] = (bf16_t)(kv[j] >> 16); } }
            { const int r = lane, e0 = w * 8; const float ws_ = gws[r]; const u32x4 vv = *(const LAS u32x4*)(Vs + r * SC_TSTR + e0);
#pragma unroll
                for (int j = 0; j < 4; ++j) { Vt[(e0 + 2 * j) * SC_TSTR + r] = (bf16_t)(vv[j] & 0xffffu); Vt[(e0 + 2 * j + 1) * SC_TSTR + r] = (bf16_t)(vv[j] >> 16);
                    Vtw[(e0 + 2 * j) * SC_TSTR + r] = f2bf(bflo(vv[j]) * ws_); Vtw[(e0 + 2 * j + 1) * SC_TSTR + r] = f2bf(bfhi(vv[j]) * ws_); }
                if (w == 4) Vtw[SC_DVS * SC_TSTR + r] = f2bf(ws_); }
            if (c + 1 < nch) SC_LOAD(c + 1);
#pragma unroll
            for (int ti = 0; ti < 2; ++ti) {
                const int id = 2 * w + ti, tt = id >> 2, st = id & 3;
                f32x4 sa = (f32x4){0.f, 0.f, 0.f, 0.f};
                if (st <= tt) {
#pragma unroll
                    for (int kk = 0; kk < 4; ++kk) {
                        const bf16x8 a = *(const LAS bf16x8*)(Qs + (tt * 16 + l15) * SC_QSTR + kk * 32 + lq * 8);
                        const bf16x8 b = *(const LAS bf16x8*)(Ks + (st * 16 + l15) * SC_QSTR + kk * 32 + lq * 8);
                        sa = __builtin_amdgcn_mfma_f32_16x16x32_bf16(a, b, sa, 0, 0, 0);
                    }
                    const int s_ = st * 16 + l15; const float as = ga[s_];
#pragma unroll
                    for (int j = 0; j < 4; ++j) { const int t_ = tt * 16 + lq * 4 + j; sa[j] = (s_ <= t_) ? sa[j] * __expf(as - gM[t_]) : 0.f; }
                }
#pragma unroll
                for (int j = 0; j < 4; ++j) Ss[(tt * 16 + lq * 4 + j) * SC_TSTR + st * 16 + l15] = f2bf(sa[j]);
            }
            __syncthreads();
            for (int id = w; id < 4 * SC_NT; id += 8) {
                const int tt = id / SC_NT, et = id - tt * SC_NT;
                f32x4 na = (f32x4){0.f, 0.f, 0.f, 0.f};
#pragma unroll
                for (int kk = 0; kk < 4; ++kk) {
                    const bf16x8 a = *(const LAS bf16x8*)(Qs + (tt * 16 + l15) * SC_QSTR + kk * 32 + lq * 8);
                    const bf16x8 b = *(const LAS bf16x8*)(Ct + (et * 16 + l15) * SC_QSTR + kk * 32 + lq * 8);
                    na = __builtin_amdgcn_mfma_f32_16x16x32_bf16(a, b, na, 0, 0, 0);
                }
#pragma unroll
                for (int j = 0; j < 4; ++j) na[j] *= gwi[tt * 16 + lq * 4 + j];
#pragma unroll
                for (int kk = 0; kk < 2; ++kk) {
                    const bf16x8 a = *(const LAS bf16x8*)(Ss + (tt * 16 + l15) * SC_TSTR + kk * 32 + lq * 8);
                    const bf16x8 b = *(const LAS bf16x8*)(Vt + (et * 16 + l15) * SC_TSTR + kk * 32 + lq * 8);
                    na = __builtin_amdgcn_mfma_f32_16x16x32_bf16(a, b, na, 0, 0, 0);
                }
#pragma unroll
                for (int j = 0; j < 4; ++j) Nm[(tt * 16 + lq * 4 + j) * SC_NSTR + et * 16 + l15] = na[j];
            }
            {
                const float carry = gsc[1];
#pragma unroll
                for (int nt = 0; nt < SC_NT; ++nt) {
                    cst[nt] = cst[nt] * carry;
#pragma unroll
                    for (int kk = 0; kk < 2; ++kk) {
                        const bf16x8 a = *(const LAS bf16x8*)(Kt + (16 * w + l15) * SC_TSTR + kk * 32 + lq * 8);
                        const bf16x8 b = *(const LAS bf16x8*)(Vtw + (nt * 16 + l15) * SC_TSTR + kk * 32 + lq * 8);
                        cst[nt] = __builtin_amdgcn_mfma_f32_16x16x32_bf16(a, b, cst[nt], 0, 0, 0);
                    }
                }
                mst = gsc[0];
            }
            __syncthreads();
            {
                const int t_ = tid >> 3, e0 = (tid & 7) * 8;
                const float den = fmaxf(fabsf(Nm[t_ * SC_NSTR + SC_DVS]), __expf(-gb[t_] - gM[t_]));
                const float rd = __builtin_amdgcn_rcpf(den);
                const f32x4 nv = *(const LAS f32x4*)(Nm + t_ * SC_NSTR + e0), nw = *(const LAS f32x4*)(Nm + t_ * SC_NSTR + e0 + 4);
                bf16_t* hp = H + ((size_t)(h * 4 + sl) * T + SC_TOK(t_)) * SC_DVS + e0;
                *(u32x4*)hp = (u32x4){cvt_pk_bf16(nv[0] * rd, nv[1] * rd), cvt_pk_bf16(nv[2] * rd, nv[3] * rd), cvt_pk_bf16(nw[0] * rd, nw[1] * rd), cvt_pk_bf16(nw[2] * rd, nw[3] * rd)};
            }
#pragma unroll
            for (int nt = 0; nt < SC_NT; ++nt)
                *(LAS u32x2*)(Ct + (nt * 16 + l15) * SC_QSTR + 16 * w + 4 * lq) = (u32x2){cvt_pk_bf16(cst[nt][0], cst[nt][1]), cvt_pk_bf16(cst[nt][2], cst[nt][3])};
            __syncthreads();
#undef SC_TOK
        }
#undef SC_LOAD
#undef SC_TOKC
        if (!samp) {
            const size_t sb = (((size_t)sidx * 2 + dir) * 4 + h) * 128;
#pragma unroll
            for (int nt = 0; nt < SC_NT - 1; ++nt)
#pragma unroll
                for (int j = 0; j < 4; ++j) p.out[OUT_C + (sb + 16 * w + 4 * lq + j) * 256 + sl * SC_DVS + nt * 16 + l15] = cst[nt][j];
            if (sl == 0) {
                if (l15 == 0) {
#pragma unroll
                    for (int j = 0; j < 4; ++j) p.out[OUT_N + sb + 16 * w + 4 * lq + j] = cst[SC_NT - 1][j];
                }
                if (tid == 0) p.out[OUT_M + ((size_t)sidx * 2 + dir) * 4 + h] = mst;
            }
        }
    }
}

#define XB_TMO      128
#define XB_XCNT(j)  (256  + 64 * (j))
#define XB_XSUB(j)  (1280 + 64 * (j))
#define XB_XGEN(j)  (2304 + 64 * (j))
#define XB_TOP      3328
#define XB_TOPGEN   3392
#define XB_SPIN_CAP (1u << 18)
__device__ __forceinline__ unsigned xb_ld(unsigned* p)              { return __hip_atomic_load(p, __ATOMIC_RELAXED, __HIP_MEMORY_SCOPE_AGENT); }
__device__ __forceinline__ unsigned xb_add(unsigned* p, unsigned v) { return __hip_atomic_fetch_add(p, v, __ATOMIC_RELAXED, __HIP_MEMORY_SCOPE_AGENT); }
__device__ __forceinline__ unsigned xb_xcc_id() { return (unsigned)__builtin_amdgcn_s_getreg((3 << 11) | 20) & 0xFu; }
#define XB_SPIN(cond, bar) do { unsigned _sp = 0; while (cond) { __builtin_amdgcn_s_sleep(1); \
    if ((++_sp & 255u) == 0u) { if (xb_ld(&(bar)[XB_TMO])) break; if (_sp > XB_SPIN_CAP) { atomicAdd(&(bar)[XB_TMO], 1u); break; } } } } while (0)
struct XcdBarrier { unsigned* bar; unsigned x; volatile LAS unsigned* st; };
__device__ __forceinline__ XcdBarrier xcd_barrier_post(unsigned* bar, volatile LAS unsigned* st) {
    XcdBarrier b; b.bar = bar; b.x = xb_xcc_id(); b.st = st;
    if (threadIdx.x == 0) (void)xb_add(&bar[XB_XCNT(b.x)], 1u);
    return b;
}
__device__ __forceinline__ void xcd_barrier_complete(unsigned* bar, unsigned x, unsigned& nloc, unsigned& nx) {
    const unsigned G = gridDim.x * gridDim.y * gridDim.z;
    unsigned sum, cnt, mine, sp = 0u;
    for (;;) {
        sum = 0u; cnt = 0u; mine = 0u;
#pragma unroll
        for (unsigned j = 0; j < 16; ++j) { const unsigned c = xb_ld(&bar[XB_XCNT(j)]); sum += c; cnt += (c > 0u) ? 1u : 0u; mine = (j == x) ? c : mine; }
        if (sum == G) break;
        __builtin_amdgcn_s_sleep(1);
        if ((++sp & 255u) == 0u) { if (xb_ld(&bar[XB_TMO])) break; if (sp > XB_SPIN_CAP) { atomicAdd(&bar[XB_TMO], 1u); break; } }
    }
    nloc = mine > 0u ? mine : 1u; nx = cnt > 0u ? cnt : 1u;
}
__device__ __forceinline__ void xcd_barrier(const XcdBarrier& b) {
    asm volatile("s_waitcnt vmcnt(0) lgkmcnt(0)" ::: "memory");
    __syncthreads();
    if (threadIdx.x == 0) {
        unsigned* bar = b.bar;
        __builtin_amdgcn_s_waitcnt(0);
        unsigned nloc = b.st[0], nx = b.st[1];
        if (nloc == 0u) { xcd_barrier_complete(bar, b.x, nloc, nx); b.st[0] = nloc; b.st[1] = nx; }
        const unsigned old = xb_add(&bar[XB_XSUB(b.x)], 1u);
        const unsigned gen = old / nloc;
        if (old + 1u == (gen + 1u) * nloc) {
            __builtin_amdgcn_fence(__ATOMIC_RELEASE, "agent");
            asm volatile("s_waitcnt vmcnt(0)" ::: "memory");
            const unsigned og = xb_add(&bar[XB_TOP], 1u);
            const unsigned tg = og / nx;
            if (og + 1u == (tg + 1u) * nx) xb_add(&bar[XB_TOPGEN], 1u);
            else XB_SPIN(xb_ld(&bar[XB_TOPGEN]) == tg, bar);
            __builtin_amdgcn_fence(__ATOMIC_ACQUIRE, "agent");
            xb_add(&bar[XB_XGEN(b.x)], 1u);
            asm volatile("s_waitcnt vmcnt(0)" ::: "memory");
        } else {
            XB_SPIN(xb_ld(&bar[XB_XGEN(b.x)]) == gen, bar);
            __builtin_amdgcn_fence(__ATOMIC_ACQUIRE, "agent");
            asm volatile("s_waitcnt vmcnt(0)" ::: "memory");
        }
    }
    __syncthreads();
}

constexpr int LDS_ST_OFF = pg8::STAGE_BYTES + 8192;
constexpr int LDS_BYTES = LDS_ST_OFF + 16;
constexpr int NPHASE = 18;

__global__ void __launch_bounds__(NTHREADS, 2) fwd_kernel(Params p) {
    extern __shared__ __attribute__((aligned(16))) unsigned char lds_raw[];
    LAS unsigned char* lds = (LAS unsigned char*)lds_raw;
    cg::grid_group grid = cg::this_grid();
    const int G = gridDim.x;
    unsigned char* ws = p.ws;
    const float* mod = (const float*)(ws + WS_MOD);
    bf16_t* XA = (bf16_t*)(ws + WS_XA);
    float* Y = p.out + OUT_Y;
#define IN(k) (p.ph_lo <= (k) && (k) < p.ph_hi)
    LAS unsigned* xst = (LAS unsigned*)(lds + LDS_ST_OFF);
    if (threadIdx.x == 0) { xst[0] = 0u; xst[1] = 0u; xst[2] = 0u; xst[3] = 0u; }
    __syncthreads();
    const XcdBarrier xb = xcd_barrier_post((unsigned*)(ws + WS_CTL), (volatile LAS unsigned*)xst);
    if (p.ph_lo < 0) grid.sync();
#define SEAM(k) do { if (IN(k) && IN((k) + 1)) xcd_barrier(xb); } while (0)
    if (IN(0)) phase_prep(p, lds);
    SEAM(0);
    if (IN(1)) phase_modulate_in(p);
    SEAM(1);
    if (IN(2)) {
        pg8::Gemm g{XA, (const bf16_t*)(ws + WS_WQKV), 1024, 0}; pg8::StaticOrder S; S.init(96, 12, G, blockIdx.x);
        EpiQKV E{(bf16_t*)(ws + WS_Q), (bf16_t*)(ws + WS_KP), (bf16_t*)(ws + WS_KS), (bf16_t*)(ws + WS_VTP), (bf16_t*)(ws + WS_VTS), p.out + OUT_K, p.out + OUT_V, (const float*)(ws + WS_ROPE)};
        pg8::gemm_phase(lds, g, S, E);
        tr_idle(p.in[23], 1024, NUP, NUP, (bf16_t*)(ws + WS_WUP0), 1, lds, 1152 % G);
        tr_idle(p.in[26], DFF, 1024, 1024, (bf16_t*)(ws + WS_WDN0), 0, lds, 1152 % G);
        tr_idle(p.in[16], 1024, 1024, 1024, (bf16_t*)(ws + WS_WO), 0, lds, 1152 % G);
    }
    SEAM(2);
    if (IN(3)) phase_attn(p, lds);
    SEAM(3);
    if (IN(4)) {
        pg8::Gemm g{XA, (const bf16_t*)(ws + WS_WO), 1024, 0}; pg8::StaticOrder S; S.init(96, 4, G, blockIdx.x, true);
        EpiRes E{p.in[0], p.in[1], Y, mod + 2 * 1024, nullptr, nullptr, nullptr};
        pg8::gemm_phase<EpiRes, true>(lds, g, S, E);
    }
    SEAM(4);
    if (IN(5)) phase_ln(p, p.in[11], p.in[12], mod, 3, true, false);
    SEAM(5);
    if (IN(6)) {
        pg8::Gemm g{XA, (const bf16_t*)(ws + WS_WUP0), 1024, 1}; pg8::StaticOrder S; S.init(100, 22, G, blockIdx.x);
        EpiFFNUp E{(bf16_t*)(ws + WS_ACT), p.in[24], p.in[25], (LAS float*)(lds + pg8::STAGE_BYTES)};
        pg8::gemm_phase<EpiFFNUp, false, true>(lds, g, S, E);
        tr_idle(p.in[17], 1024, NIN, NINP, (bf16_t*)(ws + WS_WIN), 0, lds, 2200 % G);
        tr_idle(p.in[22], 1024, 1024, 1024, (bf16_t*)(ws + WS_WOUT), 0, lds, 2200 % G);
    }
    SEAM(6);
    if (IN(7)) {
        pg8::Gemm g{(const bf16_t*)(ws + WS_ACT), (const bf16_t*)(ws + WS_WDN0), DFF, 0}; pg8::StaticOrder S; S.init(96, 4, G, blockIdx.x, true);
        EpiRes E{Y, Y + (size_t)TP * 1024, Y, mod + 5 * 1024, (const float*)(ws + WS_STAT), p.in[11], p.in[12]};
        pg8::gemm_phase<EpiRes, true>(lds, g, S, E);
    }
    SEAM(7);
    if (IN(8)) phase_ln(p, p.in[11] + 1024, p.in[12] + 1024, mod + 5 * 6144, 0, true, false);
    SEAM(8);
    if (IN(9)) {
        pg8::Gemm g{XA, (const bf16_t*)(ws + WS_WIN), 1024, 0}; pg8::StaticOrder S; S.init(96, 13, G, blockIdx.x);
        EpiIn E{(bf16_t*)(ws + WS_QKPRE), (bf16_t*)(ws + WS_V), (bf16_t*)(ws + WS_OG), (float*)(ws + WS_GATE), p.in[20]};
        pg8::gemm_phase<EpiIn, false, true>(lds, g, S, E);
    }
    SEAM(9);
    if (IN(10)) phase_mlconv(p);
    SEAM(10);
    if (IN(11)) phase_scan(p, lds);
    SEAM(11);
    if (IN(12)) phase_mlout(p);
    SEAM(12);
    if (IN(13)) {
        pg8::Gemm g{XA, (const bf16_t*)(ws + WS_WOUT), 1024, 0}; pg8::StaticOrder S; S.init(96, 4, G, blockIdx.x, false);
        EpiRes E{Y, Y + (size_t)TP * 1024, Y, mod + 5 * 6144 + 2 * 1024, (const float*)(ws + WS_STAT), p.in[11] + 1024, p.in[12] + 1024};
        pg8::gemm_phase<EpiRes, true>(lds, g, S, E);
        tr_idle(p.in[23] + (size_t)1024 * NUP, 1024, NUP, NUP, (bf16_t*)(ws + WS_WUP1), 1, lds, 384 % G);
    }
    SEAM(13);
    if (IN(14)) { phase_ln(p, p.in[11] + 2048, p.in[12] + 2048, mod + 5 * 6144, 3, true, false); }
    SEAM(14);
    if (IN(15)) {
        pg8::Gemm g{XA, (const bf16_t*)(ws + WS_WUP1), 1024, 1}; pg8::StaticOrder S; S.init(100, 22, G, blockIdx.x);
        EpiFFNUp E{(bf16_t*)(ws + WS_ACT), p.in[24] + 3 * NUP, p.in[25] + NUP, (LAS float*)(lds + pg8::STAGE_BYTES)};
        pg8::gemm_phase<EpiFFNUp, false, true>(lds, g, S, E);
        tr_idle(p.in[26] + (size_t)DFF * 1024, DFF, 1024, 1024, (bf16_t*)(ws + WS_WDN1), 0, lds, 2200 % G);
    }
    SEAM(15);
    if (IN(16)) {
        pg8::Gemm g{(const bf16_t*)(ws + WS_ACT), (const bf16_t*)(ws + WS_WDN1), DFF, 0}; pg8::StaticOrder S; S.init(96, 4, G, blockIdx.x, true);
        EpiRes E{Y, Y + (size_t)TP * 1024, Y, mod + 5 * 6144 + 5 * 1024, (const float*)(ws + WS_STAT), p.in[11] + 2048, p.in[12] + 2048};
        pg8::gemm_phase<EpiRes, true>(lds, g, S, E);
    }
    SEAM(16);
    if (IN(17)) phase_ln(p, p.in[11] + 3072, p.in[12] + 3072, mod, 0, false, true);
#undef IN
#undef SEAM
}

extern "C" void kernel_launch(void* const* d_in, const int* in_sizes, int n_in, void* d_out, int out_size, void* d_ws, size_t ws_size, hipStream_t stream) {
    static int grid = 0;
    if (grid == 0) {
        if (n_in != 27 || ws_size < WS_END) { fprintf(stderr, "kernel_launch: unexpected n_in %d / ws_size %zu (need %zu)\n", n_in, ws_size, (size_t)WS_END); grid = -1; return; }
        int dev = 0, cus = 0, per_cu = 0;
        hipGetDevice(&dev);
        hipDeviceGetAttribute(&cus, hipDeviceAttributeMultiprocessorCount, dev);
        hipFuncSetAttribute((const void*)fwd_kernel, hipFuncAttributeMaxDynamicSharedMemorySize, LDS_BYTES);
        hipOccupancyMaxActiveBlocksPerMultiprocessor(&per_cu, (const void*)fwd_kernel, NTHREADS, LDS_BYTES);
        if (per_cu < 1) per_cu = 1;
        if (per_cu > 1) per_cu = 1;
        grid = cus * per_cu;
        (void)hipGetLastError();
    }
    if (grid < 0) return;
    if (hipMemsetAsync((char*)d_ws + WS_CTL, 0, 16384, stream) != hipSuccess) { fprintf(stderr, "memset failed\n"); return; }
    Params p{};
    for (int i = 0; i < 27; ++i) p.in[i] = (const float*)d_in[i];
    p.out = (float*)d_out; p.ws = (unsigned char*)d_ws;
#if MULTI_LAUNCH
    for (int ph = 0; ph < NPHASE; ++ph) {
        p.ph_lo = ph; p.ph_hi = ph + 1;
        hipLaunchKernelGGL(fwd_kernel, dim3(grid), dim3(NTHREADS), LDS_BYTES, stream, p);
    }
#else
    p.ph_lo = 0; p.ph_hi = NPHASE;
    void* args[] = {&p};
    hipError_t e = hipLaunchCooperativeKernel((const void*)fwd_kernel, dim3(grid), dim3(NTHREADS), args, LDS_BYTES, stream);
    if (e != hipSuccess) fprintf(stderr, "cooperative launch failed: %s (grid %d)\n", hipGetErrorString(e), grid);
#endif
}
```
